# Optimizing an MI355X kernel written in HIP

```python
import math
import jax
import jax.numpy as jnp
from jax import lax
import numpy as np

D_MODEL = 1024
BATCH = 32
SEQ = 2048
DEPTH = 1

NSA_HEADS = 16
NSA_GROUPS = 4
NSA_HPG = NSA_HEADS // NSA_GROUPS
NSA_DK = 64
NSA_DV = 64
CMP_LEN = 32
CMP_STRIDE = 16
CMP_HIDDEN = 256
SEL_BLOCK = 64
SEL_TOPK = 16
WINDOW = 512
MLA_HEADS = 8
MLA_Q_RANK = 256
MLA_KV_RANK = 128
MLA_NOPE = 64
MLA_ROPE = 32
MLA_V = 128
ROPE_THETA = 10000.0
REL_BUCKETS = 32
REL_MAX_DIST = 128
D_FF = 2816
CONV_WIDTH = 3
Q_BLOCK = 128
RMS_EPS = 1e-6
NEG_INF = -1e30

IN_SPLITS = (
    ("nsa_q", NSA_HEADS * NSA_DK),
    ("k_cmp", NSA_GROUPS * NSA_DK),
    ("v_cmp", NSA_GROUPS * NSA_DV),
    ("k_slc", NSA_GROUPS * NSA_DK),
    ("v_slc", NSA_GROUPS * NSA_DV),
    ("k_win", NSA_GROUPS * NSA_DK),
    ("v_win", NSA_GROUPS * NSA_DV),
    ("nsa_gate", NSA_HEADS * 3),
    ("mla_cq", MLA_Q_RANK),
    ("mla_ckv", MLA_KV_RANK),
    ("mla_krope", MLA_ROPE),
    ("merge_a", D_MODEL),
    ("merge_b", D_MODEL),
)
IN_COLS = sum(w for _, w in IN_SPLITS)

kernel_name = "hybrid_nsa_mla_convglu_block"


def rmsnorm(x, g):
    xf = x.astype(jnp.float32)
    y = xf * lax.rsqrt(jnp.mean(xf * xf, axis=-1, keepdims=True) + RMS_EPS)
    return (y * g.astype(jnp.float32)).astype(x.dtype)


def split_columns(z):
    parts, off = {}, 0
    for name, width in IN_SPLITS:
        parts[name] = z[..., off:off + width]
        off += width
    return parts


def t5_bucket(dist):
    n = jnp.maximum(dist, 0)
    exact = REL_BUCKETS // 2
    log_ratio = jnp.log(jnp.maximum(n, exact).astype(jnp.float32) / exact) / math.log(REL_MAX_DIST / exact)
    large = jnp.minimum(exact + (log_ratio * (REL_BUCKETS - exact)).astype(jnp.int32), REL_BUCKETS - 1)
    return jnp.where(n < exact, n, large)


def compress_blocks(kv, pos_emb, w1, w2):
    B, S, G, d = kv.shape
    nc = (S - CMP_LEN) // CMP_STRIDE + 1
    idx = np.arange(nc)[:, None] * CMP_STRIDE + np.arange(CMP_LEN)[None, :]
    blocks = kv[:, idx] + pos_emb[None, None, :, None, :]
    blocks = blocks.transpose(0, 1, 3, 2, 4).reshape(B, nc, G, CMP_LEN * d)
    return jax.nn.gelu(blocks @ w1) @ w2


def nsa_one(q, kc, vc, ks, vs, kw, vw, gates, rel_table):
    S = q.shape[0]
    nc = kc.shape[0]
    nb = S // SEL_BLOCK
    n_sel = min(SEL_TOPK, nb)
    G, HPG = NSA_GROUPS, NSA_HPG
    scale = NSA_DK ** -0.5
    t = jnp.arange(S)
    qg = q.reshape(S, G, HPG, NSA_DK)
    rel_g = rel_table.reshape(REL_BUCKETS, G, HPG)

    dist_c = t[:, None] - (jnp.arange(nc) * CMP_STRIDE + CMP_LEN - 1)[None, :]
    valid_c = dist_c >= 0
    bias_c = rel_g[t5_bucket(dist_c)].transpose(2, 3, 0, 1)
    logit_c = jnp.einsum("sghd,cgd->ghsc", qg, kc).astype(jnp.float32) * scale + bias_c
    p_c = jax.nn.softmax(jnp.where(valid_c, logit_c, NEG_INF), axis=-1) * valid_c
    o_cmp = jnp.einsum("ghsc,cgd->sghd", p_c.astype(vc.dtype), vc).reshape(S, NSA_HEADS, NSA_DV)

    cs = np.arange(nc) * CMP_STRIDE
    bs = np.arange(nb) * SEL_BLOCK
    overlap = np.clip(np.minimum(cs[:, None] + CMP_LEN, bs[None, :] + SEL_BLOCK)
                      - np.maximum(cs[:, None], bs[None, :]), 0, None) / CMP_LEN
    score = jnp.einsum("ghsc,cj->gsj", p_c, jnp.asarray(overlap, dtype=jnp.float32))
    cur = (t // SEL_BLOCK)[:, None]
    j = jnp.arange(nb)[None, :]
    forced = (j == 0) | (j == cur) | (j == cur - 1)
    score = jnp.where(forced, jnp.inf, jnp.where(j > cur, -jnp.inf, score))
    sel_idx = lax.top_k(score, n_sel)[1]
    ks_blk = ks.reshape(nb, SEL_BLOCK, G, NSA_DK).transpose(2, 0, 1, 3)
    vs_blk = vs.reshape(nb, SEL_BLOCK, G, NSA_DV).transpose(2, 0, 1, 3)
    kw_pad = jnp.pad(kw, ((WINDOW, 0), (0, 0), (0, 0)))
    vw_pad = jnp.pad(vw, ((WINDOW, 0), (0, 0), (0, 0)))
    g_ix = jnp.arange(G)[:, None, None]
    n_win = WINDOW + Q_BLOCK

    def query_block(i):
        s0 = i * Q_BLOCK
        tq = s0 + jnp.arange(Q_BLOCK)
        qb = lax.dynamic_slice_in_dim(qg, s0, Q_BLOCK, 0)
        idx = lax.dynamic_slice_in_dim(sel_idx, s0, Q_BLOCK, 1)
        k_sel = ks_blk[g_ix, idx]
        v_sel = vs_blk[g_ix, idx]
        dist_s = tq[None, :, None, None] - (idx[..., None] * SEL_BLOCK + jnp.arange(SEL_BLOCK))
        bias_s = rel_g[t5_bucket(dist_s), g_ix[..., None]].transpose(0, 4, 1, 2, 3)
        logit_s = jnp.einsum("qghd,gqnkd->ghqnk", qb, k_sel).astype(jnp.float32) * scale + bias_s
        logit_s = jnp.where((dist_s >= 0)[:, None], logit_s, NEG_INF)
        p_s = jax.nn.softmax(logit_s.reshape(G, HPG, Q_BLOCK, n_sel * SEL_BLOCK), axis=-1)
        p_s = p_s.reshape(G, HPG, Q_BLOCK, n_sel, SEL_BLOCK)
        o_s = jnp.einsum("ghqnk,gqnkd->qghd", p_s.astype(v_sel.dtype), v_sel)
        k_w = lax.dynamic_slice_in_dim(kw_pad, s0, n_win, 0)
        v_w = lax.dynamic_slice_in_dim(vw_pad, s0, n_win, 0)
        kpos_w = s0 - WINDOW + jnp.arange(n_win)
        dist_w = tq[:, None] - kpos_w[None, :]
        valid_w = (dist_w >= 0) & (dist_w < WINDOW) & (kpos_w >= 0)[None, :]
        bias_w = rel_g[t5_bucket(dist_w)].transpose(2, 3, 0, 1)
        logit_w = jnp.einsum("qghd,kgd->ghqk", qb, k_w).astype(jnp.float32) * scale + bias_w
        p_w = jax.nn.softmax(jnp.where(valid_w, logit_w, NEG_INF), axis=-1)
        o_w = jnp.einsum("ghqk,kgd->qghd", p_w.astype(v_w.dtype), v_w)
        return o_s, o_w

    o_slc, o_win = lax.map(query_block, jnp.arange(S // Q_BLOCK))
    o_slc = o_slc.reshape(S, NSA_HEADS, NSA_DV)
    o_win = o_win.reshape(S, NSA_HEADS, NSA_DV)
    g = jax.nn.sigmoid(gates)
    out = g[..., 0:1] * o_cmp + g[..., 1:2] * o_slc + g[..., 2:3] * o_win
    return out.reshape(S, NSA_HEADS * NSA_DV)


def rope(x, cos, sin):
    half = x.shape[-1] // 2
    x1, x2 = x[..., :half], x[..., half:]
    return jnp.concatenate([x1 * cos - x2 * sin, x2 * cos + x1 * sin], axis=-1).astype(x.dtype)


def mla_attention(c_q, c_kv, k_rope, positions, q_norm_g, w_uq, kv_norm_g, w_ukv):
    B, S, _ = c_q.shape
    q = (rmsnorm(c_q, q_norm_g) @ w_uq).reshape(B, S, MLA_HEADS, MLA_NOPE + MLA_ROPE)
    kv = (rmsnorm(c_kv, kv_norm_g) @ w_ukv).reshape(B, S, MLA_HEADS, MLA_NOPE + MLA_V)
    q_nope, q_rope = q[..., :MLA_NOPE], q[..., MLA_NOPE:]
    k_nope, v = kv[..., :MLA_NOPE], kv[..., MLA_NOPE:]
    inv_freq = ROPE_THETA ** (-jnp.arange(0, MLA_ROPE, 2, dtype=jnp.float32) / MLA_ROPE)
    ang = positions.astype(jnp.float32)[..., None] * inv_freq
    cos, sin = jnp.cos(ang), jnp.sin(ang)
    q_rope = rope(q_rope, cos[:, :, None], sin[:, :, None])
    k_rope = rope(k_rope, cos, sin)
    scale = (MLA_NOPE + MLA_ROPE) ** -0.5
    k_pos = jnp.arange(S)

    def query_block(i):
        s0 = i * Q_BLOCK
        qn = lax.dynamic_slice_in_dim(q_nope, s0, Q_BLOCK, 1)
        qr = lax.dynamic_slice_in_dim(q_rope, s0, Q_BLOCK, 1)
        logit = (jnp.einsum("bqhd,bkhd->bhqk", qn, k_nope)
                 + jnp.einsum("bqhd,bkd->bhqk", qr, k_rope)).astype(jnp.float32) * scale
        causal = (s0 + jnp.arange(Q_BLOCK))[:, None] >= k_pos[None, :]
        p = jax.nn.softmax(jnp.where(causal, logit, NEG_INF), axis=-1)
        return jnp.einsum("bhqk,bkhd->bqhd", p.astype(v.dtype), v)

    o = lax.map(query_block, jnp.arange(S // Q_BLOCK))
    return o.transpose(1, 0, 2, 3, 4).reshape(B, S, MLA_HEADS * MLA_V)


def hybrid_mixer(h, positions, rel_table, w_in, cmp_pos_k, cmp_w1_k, cmp_w2_k,
                 cmp_pos_v, cmp_w1_v, cmp_w2_v, mla_q_norm_g, mla_w_uq,
                 mla_kv_norm_g, mla_w_ukv, w_o):
    B, S, _ = h.shape
    G = NSA_GROUPS
    p = split_columns(h @ w_in)
    q = p["nsa_q"].reshape(B, S, NSA_HEADS, NSA_DK)
    kc = compress_blocks(p["k_cmp"].reshape(B, S, G, NSA_DK), cmp_pos_k, cmp_w1_k, cmp_w2_k)
    vc = compress_blocks(p["v_cmp"].reshape(B, S, G, NSA_DV), cmp_pos_v, cmp_w1_v, cmp_w2_v)
    ks = p["k_slc"].reshape(B, S, G, NSA_DK)
    vs = p["v_slc"].reshape(B, S, G, NSA_DV)
    kw = p["k_win"].reshape(B, S, G, NSA_DK)
    vw = p["v_win"].reshape(B, S, G, NSA_DV)
    gates = p["nsa_gate"].reshape(B, S, NSA_HEADS, 3)
    o_nsa = lax.map(lambda a: nsa_one(*a, rel_table), (q, kc, vc, ks, vs, kw, vw, gates))
    o_mla = mla_attention(p["mla_cq"], p["mla_ckv"], p["mla_krope"], positions,
                          mla_q_norm_g, mla_w_uq, mla_kv_norm_g, mla_w_ukv)
    y = jax.nn.sigmoid(p["merge_a"]) * o_nsa + jax.nn.sigmoid(p["merge_b"]) * o_mla
    return y @ w_o


def conv_glu_ffn(h, w_gate, w_up, conv_w, conv_b, w_down):
    S = h.shape[1]
    g = h @ w_gate
    g_pad = jnp.pad(g, ((0, 0), (CONV_WIDTH - 1, 0), (0, 0)))
    g_conv = conv_b
    for tap in range(CONV_WIDTH):
        g_conv = g_conv + conv_w[tap] * g_pad[:, tap:tap + S]
    return (jax.nn.silu(g_conv) * (h @ w_up)) @ w_down


def setup_inputs(seed: int = 0) -> dict:
    key = jax.random.key(seed)
    keys = iter(jax.random.split(key, 40))
    L = DEPTH

    def nrm(shape, scale):
        return jax.random.normal(next(keys), shape, jnp.float32) * scale

    def gain(shape):
        return 1.0 + 0.01 * jax.random.normal(next(keys), shape, jnp.float32)

    x = nrm((BATCH, SEQ, D_MODEL), 1.0)
    c = nrm((BATCH, D_MODEL), 1.0)
    offsets = jax.random.randint(next(keys), (BATCH, 1), 0, 4096, dtype=jnp.int32)
    positions = offsets + jnp.arange(SEQ, dtype=jnp.int32)[None, :]
    return {
        "x": x,
        "c": c,
        "positions": positions,
        "rel_bias_table": nrm((REL_BUCKETS, NSA_HEADS), 0.2),
        "ada_w": nrm((L, D_MODEL, 6 * D_MODEL), D_MODEL ** -0.5),
        "ada_b": nrm((L, 6 * D_MODEL), 0.01),
        "norm_mix_g": gain((L, D_MODEL)),
        "w_in": nrm((L, D_MODEL, IN_COLS), D_MODEL ** -0.5),
        "cmp_pos_k": nrm((L, CMP_LEN, NSA_DK), 0.1),
        "cmp_w1_k": nrm((L, CMP_LEN * NSA_DK, CMP_HIDDEN), (CMP_LEN * NSA_DK) ** -0.5),
        "cmp_w2_k": nrm((L, CMP_HIDDEN, NSA_DK), CMP_HIDDEN ** -0.5),
        "cmp_pos_v": nrm((L, CMP_LEN, NSA_DV), 0.1),
        "cmp_w1_v": nrm((L, CMP_LEN * NSA_DV, CMP_HIDDEN), (CMP_LEN * NSA_DV) ** -0.5),
        "cmp_w2_v": nrm((L, CMP_HIDDEN, NSA_DV), CMP_HIDDEN ** -0.5),
        "mla_q_norm_g": gain((L, MLA_Q_RANK)),
        "mla_w_uq": nrm((L, MLA_Q_RANK, MLA_HEADS * (MLA_NOPE + MLA_ROPE)), MLA_Q_RANK ** -0.5),
        "mla_kv_norm_g": gain((L, MLA_KV_RANK)),
        "mla_w_ukv": nrm((L, MLA_KV_RANK, MLA_HEADS * (MLA_NOPE + MLA_V)), MLA_KV_RANK ** -0.5),
        "w_o": nrm((L, D_MODEL, D_MODEL), D_MODEL ** -0.5),
        "norm_ffn_g": gain((L, D_MODEL)),
        "ffn_w_gate": nrm((L, D_MODEL, D_FF), D_MODEL ** -0.5),
        "ffn_w_up": nrm((L, D_MODEL, D_FF), D_MODEL ** -0.5),
        "ffn_conv_w": nrm((L, CONV_WIDTH, D_FF), CONV_WIDTH ** -0.5),
        "ffn_conv_b": nrm((L, D_FF), 0.01),
        "ffn_w_down": nrm((L, D_FF, D_MODEL), D_FF ** -0.5),
        "final_norm_g": gain((D_MODEL,)),
    }


def reference(x, c, positions, rel_bias_table, ada_w, ada_b, norm_mix_g, w_in,
              cmp_pos_k, cmp_w1_k, cmp_w2_k, cmp_pos_v, cmp_w1_v, cmp_w2_v,
              mla_q_norm_g, mla_w_uq, mla_kv_norm_g, mla_w_ukv, w_o,
              norm_ffn_g, ffn_w_gate, ffn_w_up, ffn_conv_w, ffn_conv_b, ffn_w_down,
              final_norm_g):
    cond = jax.nn.silu(c)
    for layer in range(DEPTH):
        mod = (cond @ ada_w[layer] + ada_b[layer])[:, None, :]
        shift_m, scale_m, gate_m, shift_f, scale_f, gate_f = jnp.split(mod, 6, axis=-1)
        h = rmsnorm(x, norm_mix_g[layer]) * (1.0 + scale_m) + shift_m
        x = x + gate_m * hybrid_mixer(h, positions, rel_bias_table, w_in[layer],
                                      cmp_pos_k[layer], cmp_w1_k[layer], cmp_w2_k[layer],
                                      cmp_pos_v[layer], cmp_w1_v[layer], cmp_w2_v[layer],
                                      mla_q_norm_g[layer], mla_w_uq[layer],
                                      mla_kv_norm_g[layer], mla_w_ukv[layer], w_o[layer])
        h = rmsnorm(x, norm_ffn_g[layer]) * (1.0 + scale_f) + shift_f
        x = x + gate_f * conv_glu_ffn(h, ffn_w_gate[layer], ffn_w_up[layer],
                                      ffn_conv_w[layer], ffn_conv_b[layer], ffn_w_down[layer])
    return rmsnorm(x, final_norm_g)
```

```cpp
#include <hip/hip_runtime.h>
#include <hip/hip_cooperative_groups.h>
#include <stdint.h>
#include <stdio.h>
namespace cg = cooperative_groups;

typedef unsigned short u16;
typedef short bf16x8 __attribute__((ext_vector_type(8)));
typedef short s16x4 __attribute__((ext_vector_type(4)));
typedef float f32x4 __attribute__((ext_vector_type(4)));
typedef unsigned u32x4 __attribute__((ext_vector_type(4)));
#define DI __device__ __forceinline__

#ifndef N_LAUNCH_MODE
#define N_LAUNCH_MODE 0
#endif

constexpr int Bn = 32, Sn = 2048, Dm = 1024, Tn = Bn * Sn;
constexpr int ZC = 5120;
constexpr int FF = 2816;
constexpr int NCMP = 127;
constexpr int CROWS = Bn * NCMP * 4;
constexpr float LOG2E = 1.4426950408889634f;

constexpr size_t OFF_WIN  = 0;
constexpr size_t OFF_WO   = OFF_WIN  + (size_t)ZC * 1024 * 2;
constexpr size_t OFF_WGU  = OFF_WO   + (size_t)1024 * 1024 * 2;
constexpr size_t OFF_WDN  = OFF_WGU  + (size_t)5632 * 1024 * 2;
constexpr size_t OFF_W1K  = OFF_WDN  + (size_t)1024 * FF * 2;
constexpr size_t OFF_W1V  = OFF_W1K  + (size_t)256 * 2048 * 2;
constexpr size_t OFF_W2K  = OFF_W1V  + (size_t)256 * 2048 * 2;
constexpr size_t OFF_W2V  = OFF_W2K  + (size_t)128 * 256 * 2;
constexpr size_t OFF_WUQ  = OFF_W2V  + (size_t)128 * 256 * 2;
constexpr size_t OFF_WUKV = OFF_WUQ  + (size_t)768 * 256 * 2;
constexpr size_t OFF_B1   = OFF_WUKV + (size_t)1536 * 128 * 2;
constexpr size_t OFF_MODP = OFF_B1   + (size_t)2 * 256 * 4;
constexpr size_t OFF_MOD  = OFF_MODP + (size_t)8 * 32 * 6144 * 4;
constexpr size_t OFF_KC   = OFF_MOD  + (size_t)32 * 6144 * 4;
constexpr size_t OFF_VC   = OFF_KC   + (size_t)Bn * 4 * 128 * 64 * 2;
constexpr size_t OFF_SELM = OFF_VC   + (size_t)Bn * 4 * 128 * 64 * 2;
constexpr size_t OFF_HID  = OFF_SELM + (size_t)Tn * 4 * 4;
constexpr size_t OFF_HBUF = OFF_HID  + (size_t)2 * CROWS * 256 * 2;
constexpr size_t OFF_Z    = OFF_HBUF + (size_t)Tn * 1024 * 2;
constexpr size_t OFF_QB   = OFF_Z;
constexpr size_t OFF_KVC  = OFF_QB   + (size_t)Tn * 1024 * 2;
constexpr size_t OFF_KVS  = OFF_KVC  + (size_t)Tn * 512 * 2;
constexpr size_t OFF_KVW  = OFF_KVS  + (size_t)Tn * 512 * 2;
constexpr size_t OFF_MQ   = OFF_KVW  + (size_t)Tn * 512 * 2;
constexpr size_t OFF_MKV  = OFF_MQ   + (size_t)Tn * 256 * 2;
constexpr size_t OFF_MA   = OFF_MKV  + (size_t)Tn * 256 * 2;
constexpr size_t OFF_MB   = OFF_MA   + (size_t)Tn * 1024 * 2;
constexpr size_t OFF_KVU  = OFF_MB   + (size_t)Tn * 1024 * 2;
constexpr size_t OFF_BAR  = OFF_KVU  + (size_t)Tn * 1536 * 2;
constexpr size_t WS_NEED  = OFF_BAR + 16384;
constexpr size_t OFF_QU   = OFF_HBUF;
constexpr size_t OFF_ACT  = OFF_Z;
constexpr size_t OFF_GSIDE = OFF_KVU;
constexpr size_t OFF_USIDE = OFF_GSIDE + (size_t)512 * 4 * FF * 4;
static_assert(OFF_ACT + (size_t)Tn * FF * 2 <= OFF_MKV, "ACT overlay");

struct Params {
  const float *x, *c; const int* pos; const float *rel, *ada_w, *ada_b, *norm_mix_g, *w_in,
      *cmp_pos_k, *cmp_w1_k, *cmp_w2_k, *cmp_pos_v, *cmp_w1_v, *cmp_w2_v, *mla_q_g, *mla_w_uq, *mla_kv_g, *mla_w_ukv,
      *w_o, *norm_ffn_g, *w_gate, *w_up, *conv_w, *conv_b, *w_down, *final_g;
  float* out; unsigned char* ws;
};

#define SMEM_BYTES 74240

DI int tidx() { int t = __builtin_amdgcn_workitem_id_x(); asm volatile("" : "+v"(t)); return t; }
typedef float f32x2_ __attribute__((ext_vector_type(2)));
typedef __bf16 bf16x2_ __attribute__((ext_vector_type(2)));
DI unsigned cvtpk(float lo, float hi) { const f32x2_ v = {lo, hi}; return __builtin_bit_cast(unsigned, __builtin_convertvector(v, bf16x2_)); }
DI float bf2f(u16 v) { return __uint_as_float(((unsigned)v) << 16); }
DI float bflo(unsigned w) { return __uint_as_float(w << 16); }
DI float bfhi(unsigned w) { return __uint_as_float(w & 0xffff0000u); }
DI float sigmoidf_(float x) { return 1.0f / (1.0f + __expf(-x)); }
DI void store4(u16* dst, f32x4 v) { uint2 w; w.x = cvtpk(v[0], v[1]); w.y = cvtpk(v[2], v[3]); *(uint2*)dst = w; }
DI f32x4 load4bf(const u16* src) { uint2 w = *(const uint2*)src; return (f32x4){bflo(w.x), bfhi(w.x), bflo(w.y), bfhi(w.y)}; }
DI float ex2(float x) { return __builtin_amdgcn_exp2f(x); }
DI f32x4 mfma16(bf16x8 a, bf16x8 b, f32x4 c) { return __builtin_amdgcn_mfma_f32_16x16x32_bf16(a, b, c, 0, 0, 0); }

DI int t5_bucket(int n) {
  if (n < 16) return n;
  int b = 16;
  b += (n >= 19); b += (n >= 21); b += (n >= 24); b += (n >= 27); b += (n >= 31); b += (n >= 35); b += (n >= 40); b += (n >= 46);
  b += (n >= 52); b += (n >= 59); b += (n >= 67); b += (n >= 77); b += (n >= 87); b += (n >= 99); b += (n >= 113);
  return b;
}

DI void rope_table(const int* __restrict__ pos, float* __restrict__ cs, int gtid, int gsz) {
  for (int e = gtid; e < Tn * 16; e += gsz) {
    const int t = e >> 4, i = e & 15;
    const float inv = exp2f(-(float)i * (13.287712379549449f / 16.0f));
    const float ang = (float)pos[t] * inv;
    const double rev = (double)ang * 0.15915494309189535;
    const float fr = (float)(rev - floor(rev));
    *(float2*)(cs + (size_t)e * 2) = make_float2(__builtin_amdgcn_cosf(fr), __builtin_amdgcn_sinf(fr));
  }
}
DI void rope4(f32x4& a, f32x4& b, const float* __restrict__ cs, int t, int lq) {
  const f32x4 c01 = *(const f32x4*)(cs + (size_t)t * 32 + lq * 8), c23 = *(const f32x4*)(cs + (size_t)t * 32 + lq * 8 + 4);
  const float cv[4] = {c01[0], c01[2], c23[0], c23[2]}, sv[4] = {c01[1], c01[3], c23[1], c23[3]};
#pragma unroll
  for (int j = 0; j < 4; ++j) {
    const float x1 = a[j], x2 = b[j];
    a[j] = x1 * cv[j] - x2 * sv[j];
    b[j] = x2 * cv[j] + x1 * sv[j];
  }
}

template <bool PARTIAL> DI float modval(const Params& p, int b, int n) {
  if (PARTIAL) {
    const float* mp = (const float*)(p.ws + OFF_MODP);
    float s = p.ada_b[n];
#pragma unroll
    for (int kc = 0; kc < 8; ++kc) s += mp[(size_t)(kc * 32 + b) * 6144 + n];
    return s;
  } else {
    return ((const float*)(p.ws + OFF_MOD))[(size_t)b * 6144 + n];
  }
}

DI int map_win(int n) {
  if (n < 2560) return n;
  if (n < 2816) return 2608 + (n - 2560);
  if (n < 2944) return 2864 + (n - 2816);
  if (n < 2976) return 2992 + (n - 2944);
  if (n < 3024) return 2560 + (n - 2976);
  if (n < 3072) return -1;
  if (n < 4096) return 3024 + (n - 3072);
  return 4048 + (n - 4096);
}

DI void conv_w(const float* __restrict__ src, const float* __restrict__ src2, int ld_src, u16* __restrict__ dst, int Ndst, int K,
               int mapid, const float* __restrict__ gain, int gtid, int gsz) {
  const int total = Ndst * (K >> 3);
  for (int it = gtid; it < total; it += gsz) {
    const int k8 = it / Ndst, n = it - k8 * Ndst;
    const float* s = src; int oc = n;
    if (mapid == 1) oc = map_win(n);
    else if (mapid == 2) { const int fb = n >> 7, r = n & 127, sb = r >> 4, i = r & 15; oc = fb * 64 + (sb >> 1) * 16 + i; s = (sb & 1) ? src2 : src; }
    else if (mapid == 3) oc = (n < 64) ? n : -1;
    else if (mapid == 4) { if (n < 512) oc = (n >> 6) * 96 + (n & 63); else { const int r = n - 512; oc = (r >> 5) * 96 + 64 + (r & 31); } }
    u32x4 w = {0u, 0u, 0u, 0u};
    if (oc >= 0) {
      float v[8];
#pragma unroll
      for (int i = 0; i < 8; ++i) { float g = gain ? gain[k8 * 8 + i] : 1.0f; v[i] = s[(size_t)(k8 * 8 + i) * ld_src + oc] * g; }
      w.x = cvtpk(v[0], v[1]); w.y = cvtpk(v[2], v[3]); w.z = cvtpk(v[4], v[5]); w.w = cvtpk(v[6], v[7]);
    }
    *(u32x4*)(dst + ((size_t)(k8 >> 2) * Ndst + n) * 32 + (k8 & 3) * 8) = w;
  }
}

DI void phase0(const Params& p, int bid, int nblk, unsigned char* smem) {
  const int tid = tidx();
  float* sc = (float*)smem;
  for (int item = bid; item < 194; item += nblk) {
    if (item < 192) {
      const int kc = item / 24, nb = item % 24, n = nb * 256 + tid;
      __syncthreads();
      for (int e = tid; e < 4096; e += 256) { const int b = e >> 7, kk = e & 127; const float v = p.c[b * 1024 + kc * 128 + kk]; sc[e] = v / (1.0f + __expf(-v)); }
      __syncthreads();
      float acc[32];
#pragma unroll
      for (int b = 0; b < 32; ++b) acc[b] = 0.f;
#pragma unroll 4
      for (int kk = 0; kk < 128; ++kk) {
        const float w = p.ada_w[(size_t)(kc * 128 + kk) * 6144 + n];
#pragma unroll
        for (int b = 0; b < 32; ++b) acc[b] += sc[b * 128 + kk] * w;
      }
      float* mp = (float*)(p.ws + OFF_MODP);
#pragma unroll
      for (int b = 0; b < 32; ++b) mp[(size_t)(kc * 32 + b) * 6144 + n] = acc[b];
    } else {
      const int kv = item - 192;
      const float* pos = kv ? p.cmp_pos_v : p.cmp_pos_k;
      const float* w1 = kv ? p.cmp_w1_v : p.cmp_w1_k;
      float s = 0.f;
#pragma unroll 16
      for (int k = 0; k < 2048; ++k) s += pos[k] * w1[(size_t)k * 256 + tid];
      ((float*)(p.ws + OFF_B1))[kv * 256 + tid] = s;
    }
  }
  const int gtid = bid * 256 + tid, gsz = nblk * 256;
  conv_w(p.w_in, nullptr, 5072, (u16*)(p.ws + OFF_WIN), ZC, 1024, 1, nullptr, gtid, gsz);
  conv_w(p.w_o, nullptr, 1024, (u16*)(p.ws + OFF_WO), 1024, 1024, 0, nullptr, gtid, gsz);
  conv_w(p.w_gate, p.w_up, FF, (u16*)(p.ws + OFF_WGU), 5632, 1024, 2, nullptr, gtid, gsz);
  conv_w(p.w_down, nullptr, 1024, (u16*)(p.ws + OFF_WDN), 1024, FF, 0, nullptr, gtid, gsz);
  conv_w(p.cmp_w1_k, nullptr, 256, (u16*)(p.ws + OFF_W1K), 256, 2048, 0, nullptr, gtid, gsz);
  conv_w(p.cmp_w1_v, nullptr, 256, (u16*)(p.ws + OFF_W1V), 256, 2048, 0, nullptr, gtid, gsz);
  conv_w(p.cmp_w2_k, nullptr, 64, (u16*)(p.ws + OFF_W2K), 128, 256, 3, nullptr, gtid, gsz);
  conv_w(p.cmp_w2_v, nullptr, 64, (u16*)(p.ws + OFF_W2V), 128, 256, 3, nullptr, gtid, gsz);
  conv_w(p.mla_w_uq, nullptr, 768, (u16*)(p.ws + OFF_WUQ), 768, 256, 4, p.mla_q_g, gtid, gsz);
  conv_w(p.mla_w_ukv, nullptr, 1536, (u16*)(p.ws + OFF_WUKV), 1536, 128, 0, p.mla_kv_g, gtid, gsz);
  for (int i = gtid; i < Bn * 4 * 64; i += gsz) {
    const int bg = i >> 6, d = i & 63;
    ((u16*)(p.ws + OFF_KC))[((size_t)bg * 128 + 127) * 64 + d] = 0;
    ((u16*)(p.ws + OFF_VC))[((size_t)bg * 128 + 127) * 64 + d] = 0;
  }
}

template <bool FIRST> DI void norm_pass(const Params& p, const float* __restrict__ src, const u16* __restrict__ srcb, const float* __restrict__ g, int shift_off, int scale_off,
                                        int bid, int nblk, unsigned char* smem) {
  const int tid = tidx(), lane = tid & 63, wave = tid >> 6;
  float* gs = (float*)smem; float* sh = gs + 1024;
  u16* dst = (u16*)(p.ws + OFF_HBUF);
  if (FIRST) {
    float* mod = (float*)(p.ws + OFF_MOD);
    for (int i = bid * 256 + tid; i < 32 * 6144; i += nblk * 256) mod[i] = modval<true>(p, i / 6144, i % 6144);
    rope_table(p.pos, p.out, bid * 256 + tid, nblk * 256);
  }
  for (int item = bid; item < 512; item += nblk) {
    const int b = item >> 4;
    __syncthreads();
    for (int k = tid; k < 1024; k += 256) {
      gs[k] = g[k] * (1.0f + modval<FIRST>(p, b, scale_off + k));
      sh[k] = modval<FIRST>(p, b, shift_off + k);
    }
    __syncthreads();
    auto ldrow = [&](float4 (&d)[4], size_t row) {
#pragma unroll
      for (int i = 0; i < 4; ++i) {
        if (FIRST) d[i] = ((const float4*)(src + row * 1024))[lane + 64 * i];
        else { const f32x4 q = load4bf(srcb + row * 1024 + (lane + 64 * i) * 4); d[i] = make_float4(q[0], q[1], q[2], q[3]); }
      }
    };
    const size_t row0 = (size_t)item * 128 + wave * 32;
    float4 v[4], nv[4];
    ldrow(v, row0);
    for (int r = 0; r < 32; ++r) {
      const size_t row = row0 + r;
      if (r + 1 < 32) ldrow(nv, row + 1);
      float ss = 0.f;
#pragma unroll
      for (int i = 0; i < 4; ++i) ss += v[i].x * v[i].x + v[i].y * v[i].y + v[i].z * v[i].z + v[i].w * v[i].w;
#pragma unroll
      for (int o = 32; o >= 1; o >>= 1) ss += __shfl_xor(ss, o);
      const float rstd = rsqrtf(ss * (1.0f / 1024.0f) + 1e-6f);
#pragma unroll
      for (int i = 0; i < 4; ++i) {
        const int k = (lane + 64 * i) * 4;
        const float4 gg = *(const float4*)(gs + k), hh = *(const float4*)(sh + k);
        f32x4 o = {v[i].x * rstd * gg.x + hh.x, v[i].y * rstd * gg.y + hh.y, v[i].z * rstd * gg.z + hh.z, v[i].w * rstd * gg.w + hh.w};
        store4(dst + ((size_t)(k >> 5) * Tn + row) * 32 + (k & 31), o);
      }
#pragma unroll
      for (int i = 0; i < 4; ++i) v[i] = nv[i];
    }
  }
}

template <int NI, class XL, class EP>
DI void gemm_tile(const u16* __restrict__ W, int ldw, int f0, int t0, int K, XL xl, EP ep, unsigned char* smem) {
  constexpr int LST = 48;
  constexpr int XR = NI / 2;
  constexpr int BUF = (128 + NI * 32) * LST;
  u16* S0 = (u16*)smem;
  const int tid = tidx(), lane = tid & 63, wave = tid >> 6;
  const int wf = wave >> 1, wt = wave & 1, lr = lane & 15, lq = lane >> 4;
  const int srow = tid >> 2, sch = (tid & 3) * 8;
  f32x4 acc[4][NI];
#pragma unroll
  for (int i = 0; i < 4; ++i)
#pragma unroll
    for (int j = 0; j < NI; ++j) acc[i][j] = (f32x4){0.f, 0.f, 0.f, 0.f};
  u32x4 wr[2], xr[XR];
  const unsigned wbyte = ((unsigned)(f0 + srow * 2) * 32u + sch) * 2u;
  const unsigned xbyte = xl.rowoff(t0 + srow * XR, sch) * 2u;
  const int xrs = xl.rstride();
  const int nk = K >> 5;
  auto gload = [&](int it) {
    const int k = it * 32;
    const char* wb = (const char*)(W + (size_t)(k >> 5) * ldw * 32);
    const char* xb = (const char*)xl.kbase(k);
#pragma unroll
    for (int i = 0; i < 2; ++i) wr[i] = *(const u32x4*)(wb + wbyte + i * 64);
#pragma unroll
    for (int i = 0; i < XR; ++i) xr[i] = *(const u32x4*)(xb + xbyte + i * xrs);
  };
  auto lstore = [&](int buf) {
    u16* Ws = S0 + buf * BUF; u16* Xs = Ws + 128 * LST;
#pragma unroll
    for (int i = 0; i < 2; ++i) *(u32x4*)(Ws + (srow * 2 + i) * LST + sch) = wr[i];
#pragma unroll
    for (int i = 0; i < XR; ++i) *(u32x4*)(Xs + (srow * XR + i) * LST + sch) = xr[i];
  };
  gload(0);
  __syncthreads();
  lstore(0);
  __syncthreads();
  if (nk > 1) gload(1);
  for (int it = 0; it < nk; ++it) {
    const u16* Ws = S0 + (it & 1) * BUF; const u16* Xs = Ws + 128 * LST;
    __builtin_amdgcn_s_setprio(1);
    bf16x8 a[4];
#pragma unroll
    for (int mi = 0; mi < 4; ++mi) a[mi] = *(const bf16x8*)(Ws + (wf * 64 + mi * 16 + lr) * LST + lq * 8);
#pragma unroll
    for (int ni = 0; ni < NI; ++ni) {
      const bf16x8 b = *(const bf16x8*)(Xs + (wt * (NI * 16) + ni * 16 + lr) * LST + lq * 8);
#pragma unroll
      for (int mi = 0; mi < 4; ++mi) acc[mi][ni] = mfma16(a[mi], b, acc[mi][ni]);
    }
    __builtin_amdgcn_sched_group_barrier(0x100, 7, 0);
#pragma unroll
    for (int ni = 0; ni < NI; ++ni) { __builtin_amdgcn_sched_group_barrier(0x008, 4, 0); if (ni + 3 < NI) __builtin_amdgcn_sched_group_barrier(0x100, 1, 0); }
    __builtin_amdgcn_s_setprio(0);
    if (it + 1 < nk) lstore((it + 1) & 1);
    if (it + 2 < nk) gload(it + 2);
    __syncthreads();
  }
  ep(acc, f0 + wf * 64, t0 + wt * (NI * 16), lr, lq, wf, wt);
}

template <class XL, class EP>
DI void gemm_tile_k128(const u16* __restrict__ W, int ldw, int f0, int t0, int K, XL xl, EP ep, unsigned char* smem) {
  constexpr int LST = 144;
  u16* Ws = (u16*)smem; u16* Xs = Ws + 128 * LST;
  const int tid = tidx(), lane = tid & 63, wave = tid >> 6;
  const int wf = wave >> 1, wt = wave & 1, lr = lane & 15, lq = lane >> 4;
  const int srow = tid >> 4, sch = (tid & 15) * 8;
  f32x4 acc[4][4];
#pragma unroll
  for (int i = 0; i < 4; ++i)
#pragma unroll
    for (int j = 0; j < 4; ++j) acc[i][j] = (f32x4){0.f, 0.f, 0.f, 0.f};
  const unsigned wbyte = (((unsigned)(sch >> 5) * ldw + f0 + srow * 8) * 32u + (sch & 31)) * 2u;
  const unsigned xbyte = xl.rowoff(t0 + srow * 8, sch) * 2u;
  const int xrs = xl.rstride();
  for (int kb = 0; kb < K; kb += 128) {
    u32x4 wr[8], xr[8];
    const char* wb = (const char*)(W + (size_t)(kb >> 5) * ldw * 32);
    const char* xb = (const char*)xl.kbase(kb);
#pragma unroll
    for (int i = 0; i < 8; ++i) { wr[i] = *(const u32x4*)(wb + wbyte + i * 64); xr[i] = *(const u32x4*)(xb + xbyte + i * xrs); }
    __syncthreads();
#pragma unroll
    for (int i = 0; i < 8; ++i) { *(u32x4*)(Ws + (srow * 8 + i) * LST + sch) = wr[i]; *(u32x4*)(Xs + (srow * 8 + i) * LST + sch) = xr[i]; }
    __syncthreads();
    __builtin_amdgcn_s_setprio(1);
#pragma unroll
    for (int ks = 0; ks < 4; ++ks) {
      bf16x8 a[4];
#pragma unroll
      for (int mi = 0; mi < 4; ++mi) a[mi] = *(const bf16x8*)(Ws + (wf * 64 + mi * 16 + lr) * LST + ks * 32 + lq * 8);
#pragma unroll
      for (int ni = 0; ni < 4; ++ni) {
        const bf16x8 b = *(const bf16x8*)(Xs + (wt * 64 + ni * 16 + lr) * LST + ks * 32 + lq * 8);
#pragma unroll
        for (int mi = 0; mi < 4; ++mi) acc[mi][ni] = mfma16(a[mi], b, acc[mi][ni]);
      }
    }
    __builtin_amdgcn_s_setprio(0);
  }
  ep(acc, f0 + wf * 64, t0 + wt * 64, lr, lq, wf, wt);
}

struct Sched { int xd, rank, nloc, nx; };
template <class F> DI void for_tiles_st(int ntm, int ntn, const Sched& sc, F f) {
  if ((ntn & 7) == 0) {
    const int nsn = ntn >> 3, nsuper = (ntm >> 3) * nsn;
    for (int sp = sc.xd; sp < nsuper; sp += sc.nx) {
      const int sm = sp / nsn, sn = sp - sm * nsn;
      for (int qq = sc.rank; qq < 64; qq += sc.nloc) f(sm * 8 + (qq >> 3), sn * 8 + (qq & 7));
    }
  } else {
    const int nsn = ntn >> 2, nsuper = (ntm >> 4) * nsn;
    for (int sp = sc.xd; sp < nsuper; sp += sc.nx) {
      const int sm = sp / nsn, sn = sp - sm * nsn;
      for (int qq = sc.rank; qq < 64; qq += sc.nloc) f(sm * 16 + (qq >> 2), sn * 4 + (qq & 3));
    }
  }
}

DI int tile_id(int i, int bid, int nblk) { const int per = nblk >> 3; return i * nblk + (bid & 7) * per + (bid >> 3); }

struct XBlk { const u16* X; int T; DI const u16* kbase(int k) const { return X + (size_t)(k >> 5) * T * 32; } DI unsigned rowoff(int t, int sch) const { return (unsigned)t * 32u + sch; } DI int rstride() const { return 64; } };
struct XPlain { const u16* X; int ld; DI const u16* kbase(int k) const { return X + k; } DI unsigned rowoff(int t, int sch) const { return (unsigned)t * (unsigned)ld + sch; } DI int rstride() const { return ld * 2; } };

DI void row_rstd(const u16* X, int ld, int K, int t0, float* rs) {
  const int r = tidx() & 127;
  const u16* xp = X + (size_t)(t0 + r) * ld;
  float ss = 0.f;
  for (int k = 0; k < K; k += 8) {
    const u32x4 w = *(const u32x4*)(xp + k);
    const float a0 = bflo(w.x), a1 = bfhi(w.x), a2 = bflo(w.y), a3 = bfhi(w.y), a4 = bflo(w.z), a5 = bfhi(w.z), a6 = bflo(w.w), a7 = bfhi(w.w);
    ss += a0 * a0 + a1 * a1 + a2 * a2 + a3 * a3 + a4 * a4 + a5 * a5 + a6 * a6 + a7 * a7;
  }
  rs[r] = rsqrtf(ss / (float)K + 1e-6f);
}

DI void phase1(const Params& p, const Sched& sched, unsigned char* smem) {
  const u16* W = (const u16*)(p.ws + OFF_WIN);
  XBlk xl{(const u16*)(p.ws + OFF_HBUF), Tn};
  for_tiles_st(256, ZC / 128, sched, [&](int tm, int tn) {
    const int f0 = tn * 128, t0 = tm * 256;
    gemm_tile<8>(W, ZC, f0, t0, 1024, xl, [&](f32x4 (&acc)[4][8], int fb, int tb, int lr, int lq, int wf, int wt) {
      u16* dst; int ld, cb;
      if (tn < 8) { dst = (u16*)(p.ws + OFF_QB); ld = 1024; cb = 0; }
      else if (tn < 12) { dst = (u16*)(p.ws + OFF_KVC); ld = 512; cb = 1024; }
      else if (tn < 16) { dst = (u16*)(p.ws + OFF_KVS); ld = 512; cb = 1536; }
      else if (tn < 20) { dst = (u16*)(p.ws + OFF_KVW); ld = 512; cb = 2048; }
      else if (tn < 22) { dst = (u16*)(p.ws + OFF_MQ); ld = 256; cb = 2560; }
      else if (tn < 24) { dst = (u16*)(p.ws + OFF_MKV); ld = 256; cb = 2816; }
      else if (tn < 32) { dst = (u16*)(p.ws + OFF_MA); ld = 1024; cb = 3072; }
      else { dst = (u16*)(p.ws + OFF_MB); ld = 1024; cb = 4096; }
      if (tn == 23 && wf == 0) {
#pragma unroll
        for (int ni = 0; ni < 8; ++ni) { const int t = tb + ni * 16 + lr; rope4(acc[0][ni], acc[1][ni], p.out, t, lq); }
      }
      constexpr int EST = 136;
      u16* Ls = (u16*)smem;
      __syncthreads();
#pragma unroll
      for (int mi = 0; mi < 4; ++mi)
#pragma unroll
        for (int ni = 0; ni < 8; ++ni) store4(Ls + (wt * 128 + ni * 16 + lr) * EST + wf * 64 + mi * 16 + lq * 4, acc[mi][ni]);
      __syncthreads();
      const int tid = tidx();
#pragma unroll
      for (int i = 0; i < 16; ++i) {
        const int c = tid + 256 * i, row = c >> 4, ch = (c & 15) * 8;
        *(u32x4*)(dst + (size_t)(t0 + row) * ld + (f0 - cb) + ch) = *(const u32x4*)(Ls + row * EST + ch);
      }
    }, smem);
  });
}

DI void epi_store128(const f32x4 (&acc)[4][4], unsigned char* smem, u16* dst, int ld, int wf, int wt, int lr, int lq) {
  constexpr int EST = 136;
  u16* Ls = (u16*)smem;
  __syncthreads();
#pragma unroll
  for (int mi = 0; mi < 4; ++mi)
#pragma unroll
    for (int ni = 0; ni < 4; ++ni) store4(Ls + (wt * 64 + ni * 16 + lr) * EST + wf * 64 + mi * 16 + lq * 4, acc[mi][ni]);
  __syncthreads();
  const int tid = tidx();
#pragma unroll
  for (int i = 0; i < 8; ++i) {
    const int c = tid + 256 * i, row = c >> 4, ch = (c & 15) * 8;
    *(u32x4*)(dst + (size_t)row * ld + ch) = *(const u32x4*)(Ls + row * EST + ch);
  }
}

struct XCmp { const u16* kvc; int off;
  DI const u16* kbase(int k) const { return kvc + (size_t)(k >> 6) * 512 + off + (k & 32); }
  DI unsigned rowoff(int r, int sch) const { const int g = r & 3, bc = r >> 2, b = bc / NCMP, c = bc - b * NCMP; return (unsigned)(b * Sn + c * 16) * 512u + g * 64 + sch; }
  DI int rstride() const { return 128; } };

DI void phase2(const Params& p, int bid, int nblk, unsigned char* smem) {
  float* rs = (float*)(smem + 73728);
  const int n_c1 = 2 * 127 * 2, n_kvu = 512 * 12, n_qu = 512 * 6, ntot = n_c1 + n_kvu + n_qu;
  for (int i = 0;; ++i) {
    const int tile = tile_id(i, bid, nblk); if (tile >= ntot) break;
    if (tile < n_c1) {
      const int kv = tile / 254, r = tile % 254, tm = r >> 1, tn = r & 1;
      const u16* W = (const u16*)(p.ws + (kv ? OFF_W1V : OFF_W1K));
      XCmp xl{(const u16*)(p.ws + OFF_KVC), kv * 256};
      const float* b1 = (const float*)(p.ws + OFF_B1) + kv * 256;
      u16* hid = (u16*)(p.ws + OFF_HID) + (size_t)kv * CROWS * 256;
      gemm_tile<4>(W, 256, tn * 128, tm * 128, 2048, xl, [&](f32x4 (&acc)[4][4], int fb, int tb, int lr, int lq, int wf, int wt) {
#pragma unroll
        for (int mi = 0; mi < 4; ++mi) {
          const int f = fb + mi * 16 + lq * 4; const float4 bb = *(const float4*)(b1 + f);
#pragma unroll
          for (int ni = 0; ni < 4; ++ni) {
            const int t = tb + ni * 16 + lr; f32x4 v = acc[mi][ni]; v[0] += bb.x; v[1] += bb.y; v[2] += bb.z; v[3] += bb.w;
#pragma unroll
            for (int j = 0; j < 4; ++j) { const float xx = v[j]; const float u = 0.7978845608028654f * (xx + 0.044715f * xx * xx * xx); const float th = 1.0f - 2.0f / (__expf(2.0f * u) + 1.0f); v[j] = 0.5f * xx * (1.0f + th); }
            store4(hid + ((size_t)(f >> 5) * CROWS + t) * 32 + (f & 31), v);
          }
        }
      }, smem);
    } else if (tile < n_c1 + n_kvu) {
      const int r = tile - n_c1, tm = r / 12, tn = r % 12, t0 = tm * 128;
      const u16* X = (const u16*)(p.ws + OFF_MKV);
      __syncthreads();
      row_rstd(X, 256, 128, t0, rs);
      XPlain xl{X, 256};
      u16* kvu = (u16*)(p.ws + OFF_KVU);
      gemm_tile_k128((const u16*)(p.ws + OFF_WUKV), 1536, tn * 128, t0, 128, xl, [&](f32x4 (&acc)[4][4], int fb, int tb, int lr, int lq, int wf, int wt) {
#pragma unroll
        for (int ni = 0; ni < 4; ++ni) {
          const int t = tb + ni * 16 + lr; const float sc = rs[t - t0];
#pragma unroll
          for (int mi = 0; mi < 4; ++mi) acc[mi][ni] = acc[mi][ni] * sc;
        }
        epi_store128(acc, smem, kvu + (size_t)t0 * 1536 + tn * 128, 1536, wf, wt, lr, lq);
      }, smem);
    } else {
      const int r = tile - n_c1 - n_kvu, tm = r / 6, tn = r % 6, t0 = tm * 128;
      const u16* X = (const u16*)(p.ws + OFF_MQ);
      __syncthreads();
      row_rstd(X, 256, 256, t0, rs);
      XPlain xl{X, 256};
      u16* qu = (u16*)(p.ws + OFF_QU);
      gemm_tile_k128((const u16*)(p.ws + OFF_WUQ), 768, tn * 128, t0, 256, xl, [&](f32x4 (&acc)[4][4], int fb, int tb, int lr, int lq, int wf, int wt) {
#pragma unroll
        for (int ni = 0; ni < 4; ++ni) {
          const int t = tb + ni * 16 + lr; const float sc = rs[t - t0];
#pragma unroll
          for (int mi = 0; mi < 4; ++mi) acc[mi][ni] = acc[mi][ni] * sc;
          if (tn >= 4) { rope4(acc[0][ni], acc[1][ni], p.out, t, lq); rope4(acc[2][ni], acc[3][ni], p.out, t, lq); }
        }
        epi_store128(acc, smem, qu + (size_t)t0 * 768 + tn * 128, 768, wf, wt, lr, lq);
      }, smem);
    }
  }
}

template <int VSTB> DI void tr8(unsigned addr, s16x4 (&lo)[4], s16x4 (&hi)[4]) {
  asm volatile(
      "ds_read_b64_tr_b16 %0, %8\n\t"
      "ds_read_b64_tr_b16 %1, %8 offset:%9\n\t"
      "ds_read_b64_tr_b16 %2, %8 offset:32\n\t"
      "ds_read_b64_tr_b16 %3, %8 offset:%10\n\t"
      "ds_read_b64_tr_b16 %4, %8 offset:64\n\t"
      "ds_read_b64_tr_b16 %5, %8 offset:%11\n\t"
      "ds_read_b64_tr_b16 %6, %8 offset:96\n\t"
      "ds_read_b64_tr_b16 %7, %8 offset:%12\n\t"
      "s_waitcnt lgkmcnt(0)"
      : "=&v"(lo[0]), "=&v"(hi[0]), "=&v"(lo[1]), "=&v"(hi[1]), "=&v"(lo[2]), "=&v"(hi[2]), "=&v"(lo[3]), "=&v"(hi[3])
      : "v"(addr), "i"(16 * VSTB), "i"(16 * VSTB + 32), "i"(16 * VSTB + 64), "i"(16 * VSTB + 96)
      : "memory");
}

template <int NT, int VST> DI void pv32(f32x4 (&O)[4][NT], const u16* Vs, int krow, int dcol, const bf16x8 (&pb)[NT], int lr, int lq) {
  const unsigned addr = (unsigned)(size_t)(Vs + (krow + 4 * lq + (lr >> 2)) * VST + dcol + 4 * (lr & 3));
  s16x4 lo[4], hi[4];
  tr8<VST * 2>(addr, lo, hi);
#pragma unroll
  for (int dt = 0; dt < 4; ++dt) {
    const bf16x8 a = __builtin_shufflevector(lo[dt], hi[dt], 0, 1, 2, 3, 4, 5, 6, 7);
#pragma unroll
    for (int nt = 0; nt < NT; ++nt) O[dt][nt] = mfma16(a, pb[nt], O[dt][nt]);
  }
}

DI bf16x8 pack8(f32x4 a, f32x4 b) {
  union { unsigned u[4]; bf16x8 v; } r;
  r.u[0] = cvtpk(a[0], a[1]); r.u[1] = cvtpk(a[2], a[3]); r.u[2] = cvtpk(b[0], b[1]); r.u[3] = cvtpk(b[2], b[3]);
  return r.v;
}

template <int NT, class F> DI void softmax_step(f32x4 (&S)[4][NT], float (&m)[NT], float (&l)[NT], float (&alpha)[NT], bf16x8 (&pb)[2][NT], F f) {
#pragma unroll
  for (int nt = 0; nt < NT; ++nt) {
    float mx = -1e30f;
#pragma unroll
    for (int mt = 0; mt < 4; ++mt)
#pragma unroll
      for (int j = 0; j < 4; ++j) { const float s2 = f(mt, j, nt, S[mt][nt][j]); S[mt][nt][j] = s2; mx = fmaxf(mx, s2); }
    mx = fmaxf(mx, __shfl_xor(mx, 16)); mx = fmaxf(mx, __shfl_xor(mx, 32));
    const float mn = (mx > m[nt] + 8.0f) ? mx : m[nt];
    alpha[nt] = ex2(m[nt] - mn); m[nt] = mn;
    const float mexp = (mn < -1e29f) ? 0.f : mn;
    float sum = 0.f;
#pragma unroll
    for (int mt = 0; mt < 4; ++mt)
#pragma unroll
      for (int j = 0; j < 4; ++j) { const float pv = ex2(S[mt][nt][j] - mexp); sum += pv; S[mt][nt][j] = pv; }
    l[nt] = l[nt] * alpha[nt] + sum;
    pb[0][nt] = pack8(S[0][nt], S[1][nt]);
    pb[1][nt] = pack8(S[2][nt], S[3][nt]);
  }
}

template <int NT> DI void softmax_fast(f32x4 (&S)[4][NT], float (&m)[NT], float (&l)[NT], float (&alpha)[NT], bf16x8 (&pb)[2][NT], float sc2, const float (&bias)[NT]) {
#pragma unroll
  for (int nt = 0; nt < NT; ++nt) {
    float mxr = S[0][nt][0];
#pragma unroll
    for (int mt = 0; mt < 4; ++mt)
#pragma unroll
      for (int j = 0; j < 4; ++j) mxr = fmaxf(mxr, S[mt][nt][j]);
    mxr = fmaxf(mxr, __shfl_xor(mxr, 16)); mxr = fmaxf(mxr, __shfl_xor(mxr, 32));
    const float mx = (bias[nt] > -1e29f) ? (mxr * sc2 + bias[nt]) : -1e30f;
    const float mn = (mx > m[nt] + 8.0f) ? mx : m[nt];
    alpha[nt] = ex2(m[nt] - mn); m[nt] = mn;
    const float c = bias[nt] - ((mn < -1e29f) ? 0.f : mn);
    float sum = 0.f;
#pragma unroll
    for (int mt = 0; mt < 4; ++mt)
#pragma unroll
      for (int j = 0; j < 4; ++j) { const float pv = ex2(S[mt][nt][j] * sc2 + c); sum += pv; S[mt][nt][j] = pv; }
    l[nt] = l[nt] * alpha[nt] + sum;
    pb[0][nt] = pack8(S[0][nt], S[1][nt]);
    pb[1][nt] = pack8(S[2][nt], S[3][nt]);
  }
}

DI void mla_item(const Params& p, int it, unsigned char* smem, u16* mb_out) {
  const int tid = tidx(), lane = tid & 63, wave = tid >> 6, lr = lane & 15, lq = lane >> 4;
  const int k = it >> 9, r = it & 511, cls = r >> 8, bh = r & 255, b = bh >> 3, hp = bh & 7;
  const int pi = k >> 1, qt = (k & 1) ? (2 * pi + cls) : (15 - 2 * pi - cls);
  const int q0 = qt * 128;
  constexpr int KST = 112, VST = 144;
  u16* Ks = (u16*)smem; u16* Vs = Ks + 64 * KST;
  const u16* kvu = (const u16*)(p.ws + OFF_KVU); const u16* mkv = (const u16*)(p.ws + OFF_MKV); const u16* qu = (const u16*)(p.ws + OFF_QU);
  const size_t tb0 = (size_t)b * Sn;
  bf16x8 qf[2][3];
#pragma unroll
  for (int nt = 0; nt < 2; ++nt) {
    const size_t t = tb0 + q0 + wave * 32 + nt * 16 + lr;
    qf[nt][0] = *(const bf16x8*)(qu + t * 768 + hp * 64 + lq * 8);
    qf[nt][1] = *(const bf16x8*)(qu + t * 768 + hp * 64 + 32 + lq * 8);
    qf[nt][2] = *(const bf16x8*)(qu + t * 768 + 512 + hp * 32 + lq * 8);
  }
  f32x4 Oa[4][2], Ob[4][2];
#pragma unroll
  for (int i = 0; i < 4; ++i) { Oa[i][0] = (f32x4){0.f, 0.f, 0.f, 0.f}; Oa[i][1] = (f32x4){0.f, 0.f, 0.f, 0.f}; Ob[i][0] = (f32x4){0.f, 0.f, 0.f, 0.f}; Ob[i][1] = (f32x4){0.f, 0.f, 0.f, 0.f}; }
  float m[2] = {-1e30f, -1e30f}, l[2] = {0.f, 0.f};
  const float sc2 = 0.10206207261596577f * LOG2E;
  const int njt = q0 / 64 + 2;
  u32x4 kr[3], vr[4];
  auto ldtile = [&](int jt) {
#pragma unroll
    for (int i = 0; i < 3; ++i) { const int ch = tid + 256 * i, row = ch / 12, c = (ch % 12) * 8; const size_t t = tb0 + jt * 64 + row;
      kr[i] = (c < 64) ? *(const u32x4*)(kvu + t * 1536 + hp * 192 + c) : *(const u32x4*)(mkv + t * 256 + 128 + (c - 64)); }
#pragma unroll
    for (int i = 0; i < 4; ++i) { const int ch = tid + 256 * i, row = ch >> 4, c = (ch & 15) * 8; const size_t t = tb0 + jt * 64 + row;
      vr[i] = *(const u32x4*)(kvu + t * 1536 + hp * 192 + 64 + c); }
  };
  ldtile(0);
  const int qw0 = q0 + wave * 32;
  for (int jt = 0; jt < njt; ++jt) {
    __syncthreads();
#pragma unroll
    for (int i = 0; i < 3; ++i) { const int ch = tid + 256 * i, row = ch / 12, c = (ch % 12) * 8; *(u32x4*)(Ks + row * KST + c) = kr[i]; }
#pragma unroll
    for (int i = 0; i < 4; ++i) { const int ch = tid + 256 * i, row = ch >> 4, c = (ch & 15) * 8; *(u32x4*)(Vs + row * VST + c) = vr[i]; }
    __syncthreads();
    if (jt + 1 < njt) ldtile(jt + 1);
    const int k0 = jt * 64;
    if (k0 <= qw0 + 31) {
      f32x4 S[4][2];
#pragma unroll
      for (int mt = 0; mt < 4; ++mt) { S[mt][0] = (f32x4){0.f, 0.f, 0.f, 0.f}; S[mt][1] = (f32x4){0.f, 0.f, 0.f, 0.f}; }
      __builtin_amdgcn_s_setprio(1);
#pragma unroll
      for (int mt = 0; mt < 4; ++mt)
#pragma unroll
        for (int ks = 0; ks < 3; ++ks) {
          const bf16x8 a = *(const bf16x8*)(Ks + (mt * 16 + lr) * KST + ks * 32 + lq * 8);
          S[mt][0] = mfma16(a, qf[0][ks], S[mt][0]); S[mt][1] = mfma16(a, qf[1][ks], S[mt][1]);
        }
      __builtin_amdgcn_s_setprio(0);
      float alpha[2]; bf16x8 pb[2][2];
      if (k0 + 63 <= qw0) {
        const float zb[2] = {0.f, 0.f};
        softmax_fast<2>(S, m, l, alpha, pb, sc2, zb);
      } else {
        const int dq = qw0 + lr - k0 - lq * 4;
        softmax_step<2>(S, m, l, alpha, pb, [&](int mt, int j, int nt, float raw) {
          return ((dq + nt * 16) - (mt * 16 + j) >= 0) ? raw * sc2 : -1e30f;
        });
      }
      if (__any((alpha[0] != 1.0f) || (alpha[1] != 1.0f))) {
#pragma unroll
        for (int dt = 0; dt < 4; ++dt) { Oa[dt][0] = Oa[dt][0] * alpha[0]; Oa[dt][1] = Oa[dt][1] * alpha[1]; Ob[dt][0] = Ob[dt][0] * alpha[0]; Ob[dt][1] = Ob[dt][1] * alpha[1]; }
      }
      __builtin_amdgcn_s_setprio(1);
#pragma unroll
      for (int kk = 0; kk < 2; ++kk) {
        pv32<2, VST>(Oa, Vs, kk * 32, 0, pb[kk], lr, lq);
        pv32<2, VST>(Ob, Vs, kk * 32, 64, pb[kk], lr, lq);
      }
      __builtin_amdgcn_s_setprio(0);
    }
  }
  const u16* mb = (const u16*)(p.ws + OFF_MB);
#pragma unroll
  for (int nt = 0; nt < 2; ++nt) {
    float lt = l[nt]; lt += __shfl_xor(lt, 16); lt += __shfl_xor(lt, 32);
    const float inv = 1.0f / lt;
    const size_t t = tb0 + q0 + wave * 32 + nt * 16 + lr;
#pragma unroll
    for (int dt = 0; dt < 8; ++dt) {
      const size_t oidx = t * 1024 + hp * 128 + dt * 16 + lq * 4;
      const f32x4 gm = load4bf(mb + oidx);
      const f32x4 ov = (dt < 4) ? Oa[dt & 3][nt] : Ob[dt & 3][nt];
      f32x4 o;
#pragma unroll
      for (int j = 0; j < 4; ++j) o[j] = sigmoidf_(gm[j]) * ov[j] * inv;
      store4(mb_out + oidx, o);
    }
  }
}

DI void phase3(const Params& p, int bid, int nblk, unsigned char* smem, u16* mb_out) {
  for (int i = 0;; ++i) {
    const int tile = tile_id(i, bid, nblk); if (tile >= 254) break;
    const int kv = tile / 127, tm = tile % 127;
    XBlk xl{(const u16*)(p.ws + OFF_HID) + (size_t)kv * CROWS * 256, CROWS};
    u16* dst = (u16*)(p.ws + (kv ? OFF_VC : OFF_KC));
    gemm_tile<4>((const u16*)(p.ws + (kv ? OFF_W2V : OFF_W2K)), 128, 0, tm * 128, 256, xl, [&](f32x4 (&acc)[4][4], int fb, int tb, int lr, int lq, int wf, int wt) {
      if (wf == 0) {
#pragma unroll
        for (int ni = 0; ni < 4; ++ni) {
          const int r = tb + ni * 16 + lr, g = r & 3, bc = r >> 2, b = bc / NCMP, c = bc - b * NCMP;
#pragma unroll
          for (int mi = 0; mi < 4; ++mi) store4(dst + ((size_t)(b * 4 + g) * 128 + c) * 64 + mi * 16 + lq * 4, acc[mi][ni]);
        }
      }
    }, smem);
  }
  __syncthreads();
  for (int it = bid; it < 4096; it += nblk) { mla_item(p, it, smem, mb_out); __syncthreads(); }
}

DI void cmp_item(const Params& p, int it, unsigned char* smem) {
  const int tid = tidx(), lane = tid & 63, wave = tid >> 6, lr = lane & 15, lq = lane >> 4;
  const int b = it >> 7, g = (it >> 5) & 3, s0 = (it & 31) * 64;
  constexpr int KST = 80;
  u16* Ks = (u16*)smem; u16* Vs = Ks + 128 * KST;
  float* bt = (float*)(smem + 2 * 128 * KST * 2);
  float* scb = bt + 512;
  const u16* kc = (const u16*)(p.ws + OFF_KC) + (size_t)(b * 4 + g) * 128 * 64;
  const u16* vc = (const u16*)(p.ws + OFF_VC) + (size_t)(b * 4 + g) * 128 * 64;
  __syncthreads();
  for (int ch = tid; ch < 1024; ch += 256) { const int row = ch >> 3, c = (ch & 7) * 8;
    *(u32x4*)(Ks + row * KST + c) = *(const u32x4*)(kc + row * 64 + c);
    *(u32x4*)(Vs + row * KST + c) = *(const u32x4*)(vc + row * 64 + c); }
  for (int e = tid; e < 512; e += 256) { const int hh = e >> 7, d = e & 127; bt[e] = p.rel[t5_bucket(d) * 16 + g * 4 + hh] * LOG2E; }
  __syncthreads();
  const int tq = s0 + wave * 16 + lr;
  const size_t t = (size_t)b * Sn + tq;
  const u16* qb = (const u16*)(p.ws + OFF_QB); const u16* mkv = (const u16*)(p.ws + OFF_MKV);
  u16* abuf = (u16*)(p.ws + OFF_HBUF);
  const float sc2 = 0.125f * LOG2E;
  f32x4 Ps[8];
#pragma unroll
  for (int mt = 0; mt < 8; ++mt) Ps[mt] = (f32x4){0.f, 0.f, 0.f, 0.f};
#pragma unroll 1
  for (int hh = 0; hh < 4; ++hh) {
    const int h = g * 4 + hh;
    bf16x8 qf[2];
    qf[0] = *(const bf16x8*)(qb + t * 1024 + h * 64 + lq * 8);
    qf[1] = *(const bf16x8*)(qb + t * 1024 + h * 64 + 32 + lq * 8);
    f32x4 S[8];
    float mx = -1e30f;
#pragma unroll
    for (int mt = 0; mt < 8; ++mt) {
      f32x4 s = (f32x4){0.f, 0.f, 0.f, 0.f};
#pragma unroll
      for (int ks = 0; ks < 2; ++ks) { const bf16x8 a = *(const bf16x8*)(Ks + (mt * 16 + lr) * KST + ks * 32 + lq * 8); s = mfma16(a, qf[ks], s); }
      if ((s0 + wave * 16) - (mt * 256 + 271) >= 113) {
        const float bf = bt[hh * 128 + 127];
#pragma unroll
        for (int j = 0; j < 4; ++j) { const float s2 = s[j] * sc2 + bf; s[j] = s2; mx = fmaxf(mx, s2); }
      } else {
#pragma unroll
        for (int j = 0; j < 4; ++j) {
          const int c = mt * 16 + lq * 4 + j, dist = tq - (c * 16 + 31);
          const int di = dist < 0 ? 0 : (dist > 127 ? 127 : dist);
          const float s2 = (dist >= 0) ? (s[j] * sc2 + bt[hh * 128 + di]) : -1e30f;
          s[j] = s2; mx = fmaxf(mx, s2);
        }
      }
      S[mt] = s;
    }
    mx = fmaxf(mx, __shfl_xor(mx, 16)); mx = fmaxf(mx, __shfl_xor(mx, 32));
    float sum = 0.f;
#pragma unroll
    for (int mt = 0; mt < 8; ++mt)
#pragma unroll
      for (int j = 0; j < 4; ++j) { const float s2 = S[mt][j]; const float pv = (s2 > -1e29f) ? ex2(s2 - mx) : 0.f; S[mt][j] = pv; sum += pv; }
    sum += __shfl_xor(sum, 16); sum += __shfl_xor(sum, 32);
    const float inv = sum > 0.f ? 1.0f / sum : 0.f;
#pragma unroll
    for (int mt = 0; mt < 8; ++mt) { S[mt] = S[mt] * inv; Ps[mt] = Ps[mt] + S[mt]; }
    f32x4 O[4][1];
#pragma unroll
    for (int dt = 0; dt < 4; ++dt) O[dt][0] = (f32x4){0.f, 0.f, 0.f, 0.f};
    __builtin_amdgcn_s_setprio(1);
#pragma unroll
    for (int kk = 0; kk < 4; ++kk) { bf16x8 pb[1]; pb[0] = pack8(S[2 * kk], S[2 * kk + 1]); pv32<1, KST>(O, Vs, kk * 32, 0, pb, lr, lq); }
    __builtin_amdgcn_s_setprio(0);
    const float g0 = sigmoidf_(bf2f(mkv[t * 256 + 160 + h * 3 + 0]));
#pragma unroll
    for (int dt = 0; dt < 4; ++dt) store4(abuf + t * 1024 + h * 64 + dt * 16 + lq * 4, O[dt][0] * g0);
  }
  float own[8];
  {
    float up[8];
#pragma unroll
    for (int mt = 0; mt < 8; ++mt) up[mt] = __shfl(Ps[mt][3], (lane + 48) & 63);
#pragma unroll
    for (int mt = 0; mt < 8; ++mt) {
      const float prev = (lq >= 1) ? up[mt] : (mt >= 1 ? up[mt >= 1 ? mt - 1 : 0] : 0.f);
      own[mt] = Ps[mt][0] + Ps[mt][1] + Ps[mt][2] + 0.5f * Ps[mt][3] + 0.5f * prev;
    }
  }
  const int cur = tq >> 6;
  float* myrow = scb + (wave * 16 + lr) * 33;
#pragma unroll
  for (int mt = 0; mt < 8; ++mt) {
    const int jb = 4 * mt + lq;
    float v = own[mt];
    if (jb == 0 || jb == cur || jb == cur - 1) v = INFINITY; else if (jb > cur) v = -INFINITY;
    own[mt] = v; myrow[jb] = v;
  }
  __syncthreads();
  int rank[8];
#pragma unroll
  for (int mt = 0; mt < 8; ++mt) rank[mt] = 0;
#pragma unroll 4
  for (int i = 0; i < 32; ++i) {
    const float si = myrow[i];
#pragma unroll
    for (int mt = 0; mt < 8; ++mt) { const int jb = 4 * mt + lq; rank[mt] += (si > own[mt] || (si == own[mt] && i < jb)) ? 1 : 0; }
  }
  unsigned msk = 0;
#pragma unroll
  for (int mt = 0; mt < 8; ++mt) if (rank[mt] < 16) msk |= 1u << (4 * mt + lq);
  msk |= __shfl_xor(msk, 16); msk |= __shfl_xor(msk, 32);
  if (lq == 0) ((unsigned*)(p.ws + OFF_SELM))[t * 4 + g] = msk;
}

DI void phase4(const Params& p, int bid, int nblk, unsigned char* smem) {
  for (int it = bid; it < 4096; it += nblk) cmp_item(p, it, smem);
}

DI void selwin_item(const Params& p, int it, unsigned char* smem, u16* y_out) {
  const int tid = tidx(), lane = tid & 63, wave = tid >> 6, lr = lane & 15, lq = lane >> 4;
  const int k = it >> 9, r = it & 511, cls = r >> 7, bg = r & 127, b = bg >> 2, g = bg & 3;
  const int pi = k >> 1, lo_ = pi * 4 + cls, qt = (k & 1) ? lo_ : (63 - lo_);
  const int s0 = qt * 32, cur = s0 >> 6, h = g * 4 + wave;
  constexpr int KST = 80;
  u16* Ks = (u16*)smem; u16* Vs = Ks + 64 * KST;
  float* bt = (float*)(smem + 2 * 64 * KST * 2);
  const size_t tb0 = (size_t)b * Sn;
  const u16* qb = (const u16*)(p.ws + OFF_QB);
  __syncthreads();
  for (int e = tid; e < 512; e += 256) { const int hh = e >> 7, d = e & 127; bt[e] = p.rel[t5_bucket(d) * 16 + g * 4 + hh] * LOG2E; }
  bf16x8 qf[2][2]; unsigned mw[2];
#pragma unroll
  for (int nt = 0; nt < 2; ++nt) {
    const size_t t = tb0 + s0 + nt * 16 + lr;
    qf[nt][0] = *(const bf16x8*)(qb + t * 1024 + h * 64 + lq * 8);
    qf[nt][1] = *(const bf16x8*)(qb + t * 1024 + h * 64 + 32 + lq * 8);
    mw[nt] = ((const unsigned*)(p.ws + OFF_SELM))[t * 4 + g];
  }
  unsigned orm = mw[0] | mw[1];
  orm |= __shfl_xor(orm, 1); orm |= __shfl_xor(orm, 2); orm |= __shfl_xor(orm, 4); orm |= __shfl_xor(orm, 8);
  orm = __builtin_amdgcn_readfirstlane(orm);
  orm &= (cur >= 31) ? 0xffffffffu : ((2u << cur) - 1u);
  const float sc2 = 0.125f * LOG2E;
  const float* btw = bt + wave * 128;
  const float bfar = p.rel[31 * 16 + h] * LOG2E;
  u32x4 krA[2], vrA[2], krB[2], vrB[2];
  f32x4 Ores[4][2];
  for (int pass = 0; pass < 2; ++pass) {
    const u16* kvp = (const u16*)(p.ws + (pass ? OFF_KVW : OFF_KVS));
    unsigned rem;
    if (pass == 0) rem = orm;
    else { int jlo = (s0 - 511) >> 6; if (jlo < 0) jlo = 0; rem = ((cur >= 31) ? 0xffffffffu : ((2u << cur) - 1u)) & ~((1u << jlo) - 1u); }
    auto ldtile = [&](u32x4 (&kr)[2], u32x4 (&vr)[2], int j) {
#pragma unroll
      for (int i = 0; i < 2; ++i) { const int ch = tid + 256 * i, row = ch >> 3, c = (ch & 7) * 8; const size_t t = tb0 + j * 64 + row;
        kr[i] = *(const u32x4*)(kvp + t * 512 + g * 64 + c); vr[i] = *(const u32x4*)(kvp + t * 512 + 256 + g * 64 + c); }
    };
    auto pop = [&]() { if (!rem) return -1; const int j = __ffs(rem) - 1; rem &= rem - 1; return j; };
    f32x4 O[4][2];
#pragma unroll
    for (int i = 0; i < 4; ++i) { O[i][0] = (f32x4){0.f, 0.f, 0.f, 0.f}; O[i][1] = (f32x4){0.f, 0.f, 0.f, 0.f}; }
    float m[2] = {-1e30f, -1e30f}, l[2] = {0.f, 0.f};
    auto process = [&](u32x4 (&kr)[2], u32x4 (&vr)[2], int j, int jn) {
      __syncthreads();
#pragma unroll
      for (int i = 0; i < 2; ++i) { const int ch = tid + 256 * i, row = ch >> 3, c = (ch & 7) * 8; *(u32x4*)(Ks + row * KST + c) = kr[i]; *(u32x4*)(Vs + row * KST + c) = vr[i]; }
      __syncthreads();
      if (jn >= 0) ldtile(kr, vr, jn);
      const int k0 = j * 64;
      f32x4 S[4][2];
#pragma unroll
      for (int mt = 0; mt < 4; ++mt) { S[mt][0] = (f32x4){0.f, 0.f, 0.f, 0.f}; S[mt][1] = (f32x4){0.f, 0.f, 0.f, 0.f}; }
      __builtin_amdgcn_s_setprio(1);
#pragma unroll
      for (int mt = 0; mt < 4; ++mt)
#pragma unroll
        for (int ks = 0; ks < 2; ++ks) {
          const bf16x8 a = *(const bf16x8*)(Ks + (mt * 16 + lr) * KST + ks * 32 + lq * 8);
          S[mt][0] = mfma16(a, qf[0][ks], S[mt][0]); S[mt][1] = mfma16(a, qf[1][ks], S[mt][1]);
        }
      __builtin_amdgcn_s_setprio(0);
      float alpha[2]; bf16x8 pb[2][2];
      const bool far = (s0 - (k0 + 63)) >= 113;
      if (far && (pass == 0 || (s0 + 31 - k0) < 512)) {
        float bs[2];
#pragma unroll
        for (int nt = 0; nt < 2; ++nt) bs[nt] = (pass == 0 && !((mw[nt] >> j) & 1u)) ? -1e30f : bfar;
        softmax_fast<2>(S, m, l, alpha, pb, sc2, bs);
      } else {
        const int dq = s0 + lr - k0 - lq * 4;
        float cb[2];
#pragma unroll
        for (int nt = 0; nt < 2; ++nt) cb[nt] = (pass == 0 && !((mw[nt] >> j) & 1u)) ? -1e30f : 0.f;
        if (j == cur) {
          softmax_step<2>(S, m, l, alpha, pb, [&](int mt, int jj, int nt, float raw) {
            const int dist = (dq + nt * 16) - (mt * 16 + jj);
            const int di = dist < 0 ? 0 : dist;
            const float s2 = raw * sc2 + (btw[di] + cb[nt]);
            return dist >= 0 ? s2 : -1e30f;
          });
        } else if (far) {
          softmax_step<2>(S, m, l, alpha, pb, [&](int mt, int jj, int nt, float raw) {
            const int dist = (dq + nt * 16) - (mt * 16 + jj);
            return dist < 512 ? (raw * sc2 + bfar) : -1e30f;
          });
        } else {
          softmax_step<2>(S, m, l, alpha, pb, [&](int mt, int jj, int nt, float raw) {
            const int dist = (dq + nt * 16) - (mt * 16 + jj);
            const int di = dist > 127 ? 127 : dist;
            return raw * sc2 + (btw[di] + cb[nt]);
          });
        }
      }
      if (__any((alpha[0] != 1.0f) || (alpha[1] != 1.0f))) {
#pragma unroll
        for (int dt = 0; dt < 4; ++dt) { O[dt][0] = O[dt][0] * alpha[0]; O[dt][1] = O[dt][1] * alpha[1]; }
      }
      __builtin_amdgcn_s_setprio(1);
#pragma unroll
      for (int kk = 0; kk < 2; ++kk) pv32<2, KST>(O, Vs, kk * 32, 0, pb[kk], lr, lq);
      __builtin_amdgcn_s_setprio(0);
    };
    int ja = pop(), jb = pop();
    if (ja >= 0) ldtile(krA, vrA, ja);
    if (jb >= 0) ldtile(krB, vrB, jb);
    while (ja >= 0) {
      const int jc = pop();
      process(krA, vrA, ja, jc);
      if (jb < 0) break;
      const int jd = pop();
      process(krB, vrB, jb, jd);
      ja = jc; jb = jd;
    }
#pragma unroll
    for (int nt = 0; nt < 2; ++nt) {
      float lt = l[nt]; lt += __shfl_xor(lt, 16); lt += __shfl_xor(lt, 32);
      const size_t t = tb0 + s0 + nt * 16 + lr;
      const float gt = sigmoidf_(bf2f(((const u16*)(p.ws + OFF_MKV))[t * 256 + 160 + h * 3 + 1 + pass]));
      const float f = gt / lt;
#pragma unroll
      for (int dt = 0; dt < 4; ++dt) { if (pass == 0) Ores[dt][nt] = O[dt][nt] * f; else Ores[dt][nt] = Ores[dt][nt] + O[dt][nt] * f; }
    }
  }
  const u16* ma = (const u16*)(p.ws + OFF_MA); const u16* mbp = (const u16*)(p.ws + OFF_MB); const u16* ab = (const u16*)(p.ws + OFF_HBUF);
#pragma unroll
  for (int nt = 0; nt < 2; ++nt) {
    const size_t t = tb0 + s0 + nt * 16 + lr;
#pragma unroll
    for (int dt = 0; dt < 4; ++dt) {
      const size_t idx = t * 1024 + h * 64 + dt * 16 + lq * 4;
      const f32x4 a = load4bf(ab + idx), mav = load4bf(ma + idx), mbv = load4bf(mbp + idx);
      f32x4 y;
#pragma unroll
      for (int j = 0; j < 4; ++j) y[j] = sigmoidf_(mav[j]) * (a[j] + Ores[dt][nt][j]) + mbv[j];
      { const int col = h * 64 + dt * 16 + lq * 4; store4(y_out + ((size_t)(col >> 5) * Tn + t) * 32 + (col & 31), y); }
    }
  }
}

DI void phase5(const Params& p, int bid, int nblk, unsigned char* smem, u16* y_out) {
  for (int it = bid; it < 8192; it += nblk) selwin_item(p, it, smem, y_out);
}

DI void phase6(const Params& p, const Sched& sched, unsigned char* smem) {
  XBlk xl{(const u16*)(p.ws + OFF_KVU), Tn};
  const float* mod = (const float*)(p.ws + OFF_MOD);
  u16* x1b = (u16*)(p.ws + OFF_MA);
  for_tiles_st(256, 8, sched, [&](int tm, int tn) {
    gemm_tile<8>((const u16*)(p.ws + OFF_WO), 1024, tn * 128, tm * 256, 1024, xl, [&](f32x4 (&acc)[4][8], int fb, int tb, int lr, int lq, int wf, int wt) {
      constexpr int EST = 136;
      u16* Ls = (u16*)smem;
      const int b = tb >> 11;
      __syncthreads();
#pragma unroll
      for (int mi = 0; mi < 4; ++mi) {
        const int f = fb + mi * 16 + lq * 4; const float4 gm = *(const float4*)(mod + (size_t)b * 6144 + 2048 + f);
#pragma unroll
        for (int ni = 0; ni < 8; ++ni) {
          const f32x4 o = {gm.x * acc[mi][ni][0], gm.y * acc[mi][ni][1], gm.z * acc[mi][ni][2], gm.w * acc[mi][ni][3]};
          store4(Ls + (wt * 128 + ni * 16 + lr) * EST + wf * 64 + mi * 16 + lq * 4, o);
        }
      }
      __syncthreads();
      const int tid = tidx();
#pragma unroll
      for (int i = 0; i < 16; ++i) {
        const int c = tid + 256 * i, row = c >> 4, ch = (c & 15) * 8;
        const size_t gi = (size_t)(tm * 256 + row) * 1024 + tn * 128 + ch;
        const u32x4 sv = *(const u32x4*)(Ls + row * EST + ch);
        const f32x4 x0 = *(const f32x4*)(p.x + gi), x1 = *(const f32x4*)(p.x + gi + 4);
        u32x4 w;
        w.x = cvtpk(x0[0] + bflo(sv.x), x0[1] + bfhi(sv.x)); w.y = cvtpk(x0[2] + bflo(sv.y), x0[3] + bfhi(sv.y));
        w.z = cvtpk(x1[0] + bflo(sv.z), x1[1] + bfhi(sv.z)); w.w = cvtpk(x1[2] + bflo(sv.w), x1[3] + bfhi(sv.w));
        *(u32x4*)(x1b + gi) = w;
      }
    }, smem);
  });
}

DI void phase8(const Params& p, const Sched& sched, unsigned char* smem) {
  XBlk xl{(const u16*)(p.ws + OFF_HBUF), Tn};
  u16* act = (u16*)(p.ws + OFF_ACT);
  float* gside = (float*)(p.ws + OFF_GSIDE); float* uside = (float*)(p.ws + OFF_USIDE);
  float* gl = (float*)smem;
  for_tiles_st(256, 44, sched, [&](int tm, int tn) {
    gemm_tile<8>((const u16*)(p.ws + OFF_WGU), 5632, tn * 128, tm * 256, 1024, xl, [&](f32x4 (&acc)[4][8], int fb, int tb, int lr, int lq, int wf, int wt) {
      u16* Ls = (u16*)(smem + 36864);
#pragma unroll
      for (int h2 = 0; h2 < 2; ++h2) {
        const int fl = wf * 16 + lq * 4, fc = (2 * wf + h2) * 16 + lq * 4, F = tn * 64 + fc;
        __syncthreads();
#pragma unroll
        for (int ni = 0; ni < 8; ++ni) *(f32x4*)(gl + (wt * 128 + ni * 16 + lr) * 36 + fl) = acc[2 * h2][ni];
        __syncthreads();
        const float4 w0 = *(const float4*)(p.conv_w + F), w1 = *(const float4*)(p.conv_w + FF + F), w2 = *(const float4*)(p.conv_w + 2 * FF + F), cb = *(const float4*)(p.conv_b + F);
#pragma unroll
        for (int ni = 0; ni < 8; ++ni) {
          const int row = wt * 128 + ni * 16 + lr;
          const f32x4 gv = acc[2 * h2][ni], uv = acc[2 * h2 + 1][ni];
          if (row >= 2) {
            const f32x4 g1 = *(const f32x4*)(gl + (row - 1) * 36 + fl), g2 = *(const f32x4*)(gl + (row - 2) * 36 + fl);
            f32x4 o;
            o[0] = cb.x + w0.x * g2[0] + w1.x * g1[0] + w2.x * gv[0];
            o[1] = cb.y + w0.y * g2[1] + w1.y * g1[1] + w2.y * gv[1];
            o[2] = cb.z + w0.z * g2[2] + w1.z * g1[2] + w2.z * gv[2];
            o[3] = cb.w + w0.w * g2[3] + w1.w * g1[3] + w2.w * gv[3];
#pragma unroll
            for (int j = 0; j < 4; ++j) o[j] = o[j] * sigmoidf_(o[j]) * uv[j];
            store4(Ls + row * 72 + fc, o);
          } else {
            *(f32x4*)(gside + ((size_t)tm * 4 + row) * FF + F) = gv;
            *(f32x4*)(uside + ((size_t)tm * 2 + row) * FF + F) = uv;
          }
          if (row >= 254) *(f32x4*)(gside + ((size_t)tm * 4 + 2 + (row - 254)) * FF + F) = gv;
        }
      }
      __syncthreads();
      const int tid = tidx(), F0 = tn * 64;
#pragma unroll
      for (int i = 0; i < 8; ++i) {
        const int c = tid + 256 * i, fblk = c >> 10, row = (c & 1023) >> 2, ch = (c & 3) * 8;
        if (row >= 2) *(u32x4*)(act + ((size_t)((F0 >> 5) + fblk) * Tn + (size_t)tm * 256 + row) * 32 + ch) = *(const u32x4*)(Ls + row * 72 + fblk * 32 + ch);
      }
    }, smem);
  });
}

DI void phase8b(const Params& p, int bid, int nblk) {
  const float* gside = (const float*)(p.ws + OFF_GSIDE); const float* uside = (const float*)(p.ws + OFF_USIDE);
  u16* act = (u16*)(p.ws + OFF_ACT);
  const int total = 256 * 2 * (FF / 4);
  for (int i = bid * 256 + tidx(); i < total; i += nblk * 256) {
    const int f4 = i % (FF / 4), rr = i / (FF / 4), r = rr & 1, tm = rr >> 1, F = f4 * 4;
    const bool first = (tm & 7) == 0;
    const f32x4 z = {0.f, 0.f, 0.f, 0.f};
    const f32x4 gv = *(const f32x4*)(gside + ((size_t)tm * 4 + r) * FF + F);
    f32x4 g1, g2;
    if (r == 1) { g1 = *(const f32x4*)(gside + ((size_t)tm * 4 + 0) * FF + F); g2 = first ? z : *(const f32x4*)(gside + ((size_t)(tm - 1) * 4 + 3) * FF + F); }
    else { g1 = first ? z : *(const f32x4*)(gside + ((size_t)(tm - 1) * 4 + 3) * FF + F); g2 = first ? z : *(const f32x4*)(gside + ((size_t)(tm - 1) * 4 + 2) * FF + F); }
    const f32x4 uv = *(const f32x4*)(uside + ((size_t)tm * 2 + r) * FF + F);
    const f32x4 w0 = *(const f32x4*)(p.conv_w + F), w1 = *(const f32x4*)(p.conv_w + FF + F), w2 = *(const f32x4*)(p.conv_w + 2 * FF + F), cb = *(const f32x4*)(p.conv_b + F);
    f32x4 o = cb + w0 * g2 + w1 * g1 + w2 * gv;
#pragma unroll
    for (int j = 0; j < 4; ++j) o[j] = o[j] * sigmoidf_(o[j]) * uv[j];
    store4(act + ((size_t)(F >> 5) * Tn + (size_t)tm * 256 + r) * 32 + (F & 31), o);
  }
}

DI void phase9(const Params& p, const Sched& sched, unsigned char* smem) {
  XBlk xl{(const u16*)(p.ws + OFF_ACT), Tn};
  const float* mod = (const float*)(p.ws + OFF_MOD);
  const u16* x1b = (const u16*)(p.ws + OFF_MA); u16* x2b = (u16*)(p.ws + OFF_MB);
  for_tiles_st(256, 8, sched, [&](int tm, int tn) {
    gemm_tile<8>((const u16*)(p.ws + OFF_WDN), 1024, tn * 128, tm * 256, FF, xl, [&](f32x4 (&acc)[4][8], int fb, int tb, int lr, int lq, int wf, int wt) {
      constexpr int EST = 136;
      u16* Ls = (u16*)smem;
      const int b = tb >> 11;
      __syncthreads();
#pragma unroll
      for (int mi = 0; mi < 4; ++mi) {
        const int f = fb + mi * 16 + lq * 4; const float4 gm = *(const float4*)(mod + (size_t)b * 6144 + 5120 + f);
#pragma unroll
        for (int ni = 0; ni < 8; ++ni) {
          const f32x4 o = {gm.x * acc[mi][ni][0], gm.y * acc[mi][ni][1], gm.z * acc[mi][ni][2], gm.w * acc[mi][ni][3]};
          store4(Ls + (wt * 128 + ni * 16 + lr) * EST + wf * 64 + mi * 16 + lq * 4, o);
        }
      }
      __syncthreads();
      const int tid = tidx();
#pragma unroll
      for (int i = 0; i < 16; ++i) {
        const int c = tid + 256 * i, row = c >> 4, ch = (c & 15) * 8;
        const size_t gi = (size_t)(tm * 256 + row) * 1024 + tn * 128 + ch;
        const u32x4 sv = *(const u32x4*)(Ls + row * EST + ch), xv = *(const u32x4*)(x1b + gi);
        u32x4 w;
        w.x = cvtpk(bflo(xv.x) + bflo(sv.x), bfhi(xv.x) + bfhi(sv.x)); w.y = cvtpk(bflo(xv.y) + bflo(sv.y), bfhi(xv.y) + bfhi(sv.y));
        w.z = cvtpk(bflo(xv.z) + bflo(sv.z), bfhi(xv.z) + bfhi(sv.z)); w.w = cvtpk(bflo(xv.w) + bflo(sv.w), bfhi(xv.w) + bfhi(sv.w));
        *(u32x4*)(x2b + gi) = w;
      }
    }, smem);
  });
}

DI void phase10(const Params& p, int bid, int nblk) {
  const int lane = tidx() & 63, wave = tidx() >> 6;
  const u16* x2 = (const u16*)(p.ws + OFF_MB);
  f32x4 g4[4];
#pragma unroll
  for (int i = 0; i < 4; ++i) g4[i] = *(const f32x4*)(p.final_g + (lane + 64 * i) * 4);
  auto ldrow = [&](uint2 (&d)[4], int row) {
#pragma unroll
    for (int i = 0; i < 4; ++i) d[i] = *(const uint2*)(x2 + (size_t)row * 1024 + (lane + 64 * i) * 4);
  };
  const int step = nblk * 4;
  int row = bid * 4 + wave;
  uint2 cur[4], nxt[4];
  if (row < Tn) ldrow(cur, row);
  for (; row < Tn; row += step) {
    if (row + step < Tn) ldrow(nxt, row + step);
    f32x4 v[4]; float ss = 0.f;
#pragma unroll
    for (int i = 0; i < 4; ++i) { v[i] = (f32x4){bflo(cur[i].x), bfhi(cur[i].x), bflo(cur[i].y), bfhi(cur[i].y)}; ss += v[i][0] * v[i][0] + v[i][1] * v[i][1] + v[i][2] * v[i][2] + v[i][3] * v[i][3]; }
#pragma unroll
    for (int o = 32; o >= 1; o >>= 1) ss += __shfl_xor(ss, o);
    const float rstd = rsqrtf(ss * (1.0f / 1024.0f) + 1e-6f);
    f32x4* xr = (f32x4*)(p.out + (size_t)row * 1024);
#pragma unroll
    for (int i = 0; i < 4; ++i) xr[lane + 64 * i] = v[i] * rstd * g4[i];
#pragma unroll
    for (int i = 0; i < 4; ++i) cur[i] = nxt[i];
  }
}

#define XB_TMO      128
#define XB_XCNT(j)  (256  + 64 * (j))
#define XB_XSUB(j)  (1280 + 64 * (j))
#define XB_XGEN(j)  (2304 + 64 * (j))
#define XB_TOP      3328
#define XB_TOPGEN   3392
#define XCD_BAR_WORDS 3456
#define XB_SPIN_CAP (1u << 20)
#define LAS __attribute__((address_space(3)))
DI unsigned xb_ld(unsigned* p) { return __hip_atomic_load(p, __ATOMIC_RELAXED, __HIP_MEMORY_SCOPE_AGENT); }
DI unsigned xb_add(unsigned* p, unsigned v) { return __hip_atomic_fetch_add(p, v, __ATOMIC_RELAXED, __HIP_MEMORY_SCOPE_AGENT); }
DI unsigned xb_xcc_id() { return (unsigned)__builtin_amdgcn_s_getreg((3 << 11) | 20) & 0xFu; }
#define XB_SPIN(cond, bar) do { unsigned _sp = 0; while (cond) { __builtin_amdgcn_s_sleep(1); \
    if ((++_sp & 255u) == 0u) { if (xb_ld(&(bar)[XB_TMO])) break; if (_sp > XB_SPIN_CAP) { atomicAdd(&(bar)[XB_TMO], 1u); break; } } } } while (0)
struct XcdBarrier { unsigned* bar; unsigned x; volatile LAS unsigned* st; };
DI XcdBarrier xcd_barrier_post(unsigned* bar, volatile LAS unsigned* st) {
  XcdBarrier b; b.bar = bar; b.x = xb_xcc_id(); b.st = st;
  if (tidx() == 0) st[2] = xb_add(&bar[XB_XCNT(b.x)], 1u);
  return b;
}
DI void xcd_barrier_complete(unsigned* bar, unsigned x, unsigned& nloc, unsigned& nx) {
  const unsigned G = gridDim.x * gridDim.y * gridDim.z;
  unsigned sum, cnt, mine, sp = 0u;
  for (;;) {
    sum = 0u; cnt = 0u; mine = 0u;
#pragma unroll
    for (unsigned j = 0; j < 16; ++j) { const unsigned c = xb_ld(&bar[XB_XCNT(j)]); sum += c; cnt += (c > 0u) ? 1u : 0u; mine = (j == x) ? c : mine; }
    if (sum == G) break;
    __builtin_amdgcn_s_sleep(1);
    if ((++sp & 255u) == 0u) { if (xb_ld(&bar[XB_TMO])) break; if (sp > XB_SPIN_CAP) { atomicAdd(&bar[XB_TMO], 1u); break; } }
  }
  nloc = mine > 0u ? mine : 1u; nx = cnt > 0u ? cnt : 1u;
}
DI void xcd_barrier(const XcdBarrier& b) {
  asm volatile("s_waitcnt vmcnt(0)" ::: "memory");
  __syncthreads();
  if (tidx() == 0) {
    unsigned* bar = b.bar;
    __builtin_amdgcn_s_waitcnt(0);
    unsigned nloc = b.st[0], nx = b.st[1];
    if (nloc == 0u) { xcd_barrier_complete(bar, b.x, nloc, nx); b.st[0] = nloc; b.st[1] = nx; }
    const unsigned old = xb_add(&bar[XB_XSUB(b.x)], 1u);
    const unsigned gen = old / nloc;
    if (old + 1u == (gen + 1u) * nloc) {
      __builtin_amdgcn_fence(__ATOMIC_RELEASE, "agent");
      asm volatile("s_waitcnt vmcnt(0)" ::: "memory");
      const unsigned og = xb_add(&bar[XB_TOP], 1u);
      const unsigned tg = og / nx;
      if (og + 1u == (tg + 1u) * nx) xb_add(&bar[XB_TOPGEN], 1u);
      else XB_SPIN(xb_ld(&bar[XB_TOPGEN]) == tg, bar);
      __builtin_amdgcn_fence(__ATOMIC_ACQUIRE, "agent");
      xb_add(&bar[XB_XGEN(b.x)], 1u);
      asm volatile("s_waitcnt vmcnt(0)" ::: "memory");
    } else {
      XB_SPIN(xb_ld(&bar[XB_XGEN(b.x)]) == gen, bar);
      __builtin_amdgcn_fence(__ATOMIC_ACQUIRE, "agent");
      asm volatile("s_waitcnt vmcnt(0)" ::: "memory");
    }
  }
  __syncthreads();
}

DI void run_phase(const Params& p, int ph, int bid, int nblk, unsigned char* smem) {
  const Sched sched{bid & 7, bid >> 3, nblk >> 3, 8};
  switch (ph) {
    case 0: phase0(p, bid, nblk, smem); break;
    case 1: norm_pass<true>(p, p.x, nullptr, p.norm_mix_g, 0, 1024, bid, nblk, smem); break;
    case 2: phase1(p, sched, smem); break;
    case 3: phase2(p, bid, nblk, smem); break;
    case 4: phase3(p, bid, nblk, smem, (u16*)(p.ws + OFF_MB)); break;
    case 5: phase4(p, bid, nblk, smem); break;
    case 6: phase5(p, bid, nblk, smem, (u16*)(p.ws + OFF_KVU)); break;
    case 7: phase6(p, sched, smem); break;
    case 8: norm_pass<false>(p, nullptr, (const u16*)(p.ws + OFF_MA), p.norm_ffn_g, 3072, 4096, bid, nblk, smem); break;
    case 9: phase8(p, sched, smem); break;
    case 10: phase8b(p, bid, nblk); break;
    case 11: phase9(p, sched, smem); break;
    case 12: phase10(p, bid, nblk); break;
  }
}
constexpr int NPHASE = 13;

__global__ void __launch_bounds__(256, 2) mega_kernel(Params p) {
  __shared__ __attribute__((aligned(16))) unsigned char smem[SMEM_BYTES];
  cg::grid_group grid = cg::this_grid();
  const int bid = blockIdx.x, nblk = gridDim.x;
  __shared__ u32x4 xb_words;
  if (tidx() == 0) xb_words = (u32x4){0u, 0u, 0u, 0u};
  __syncthreads();
  const XcdBarrier xb = xcd_barrier_post((unsigned*)(p.ws + OFF_BAR), (volatile LAS unsigned*)&xb_words);
#ifndef DUP_PHASE
#define DUP_PHASE -1
#endif
#define DUP(k, stmt) if (DUP_PHASE == k) { stmt; xcd_barrier(xb); }
  if (p.ws == nullptr) grid.sync();
  phase0(p, bid, nblk, smem); xcd_barrier(xb);
  DUP(0, phase0(p, bid, nblk, smem))
  norm_pass<true>(p, p.x, nullptr, p.norm_mix_g, 0, 1024, bid, nblk, smem); xcd_barrier(xb);
  if (tidx() == 0) {
    unsigned dense = 0;
    for (unsigned j = 0; j < 16; ++j) { const unsigned c = xb_ld(&xb.bar[XB_XCNT(j)]); if (j < xb.x && c > 0u) ++dense; }
    xb_words.w = dense;
  }
  __syncthreads();
  const Sched sched{(int)xb_words.w, (int)xb_words.z, (int)xb_words.x, (int)xb_words.y};
  DUP(1, phase1(p, sched, smem))
  phase1(p, sched, smem); xcd_barrier(xb);
  DUP(2, phase2(p, bid, nblk, smem))
  phase2(p, bid, nblk, smem); xcd_barrier(xb);
  DUP(3, phase3(p, bid, nblk, smem, (u16*)p.out))
  phase3(p, bid, nblk, smem, (u16*)(p.ws + OFF_MB)); xcd_barrier(xb);
  DUP(4, phase4(p, bid, nblk, smem))
  phase4(p, bid, nblk, smem); xcd_barrier(xb);
  DUP(5, phase5(p, bid, nblk, smem, (u16*)p.out))
  phase5(p, bid, nblk, smem, (u16*)(p.ws + OFF_KVU)); xcd_barrier(xb);
  DUP(6, phase6(p, sched, smem))
  phase6(p, sched, smem); xcd_barrier(xb);
  norm_pass<false>(p, nullptr, (const u16*)(p.ws + OFF_MA), p.norm_ffn_g, 3072, 4096, bid, nblk, smem); xcd_barrier(xb);
  DUP(8, phase8(p, sched, smem))
  phase8(p, sched, smem); xcd_barrier(xb);
  phase8b(p, bid, nblk); xcd_barrier(xb);
  phase9(p, sched, smem); xcd_barrier(xb);
  phase10(p, bid, nblk);
}

#if N_LAUNCH_MODE != 0
__global__ void __launch_bounds__(256, 2) phase_kernel(Params p, int ph) {
  __shared__ __attribute__((aligned(16))) unsigned char smem[SMEM_BYTES];
  run_phase(p, ph, blockIdx.x, gridDim.x, smem);
}
#endif

#ifdef PHASE_DEBUG
template <int PH> __global__ void __launch_bounds__(256, 2) phase_dbg(Params p) {
  __shared__ __attribute__((aligned(16))) unsigned char smem[SMEM_BYTES];
  run_phase(p, PH, blockIdx.x, gridDim.x, smem);
}
template __global__ void phase_dbg<0>(Params); template __global__ void phase_dbg<1>(Params); template __global__ void phase_dbg<2>(Params);
template __global__ void phase_dbg<3>(Params); template __global__ void phase_dbg<4>(Params); template __global__ void phase_dbg<5>(Params);
template __global__ void phase_dbg<6>(Params); template __global__ void phase_dbg<7>(Params); template __global__ void phase_dbg<8>(Params);
template __global__ void phase_dbg<9>(Params); template __global__ void phase_dbg<10>(Params); template __global__ void phase_dbg<11>(Params);
template __global__ void phase_dbg<12>(Params);
#endif

extern "C" void kernel_launch(void* const* d_in, const int* in_sizes, int n_in, void* d_out, int out_size, void* d_ws, size_t ws_size,
                              hipStream_t stream) {
  if (ws_size < WS_NEED) { fprintf(stderr, "workspace too small: %zu < %zu\n", ws_size, (size_t)WS_NEED); return; }
  Params p{};
  p.x = (const float*)d_in[0]; p.c = (const float*)d_in[1]; p.pos = (const int*)d_in[2]; p.rel = (const float*)d_in[3];
  p.ada_w = (const float*)d_in[4]; p.ada_b = (const float*)d_in[5]; p.norm_mix_g = (const float*)d_in[6]; p.w_in = (const float*)d_in[7];
  p.cmp_pos_k = (const float*)d_in[8]; p.cmp_w1_k = (const float*)d_in[9]; p.cmp_w2_k = (const float*)d_in[10];
  p.cmp_pos_v = (const float*)d_in[11]; p.cmp_w1_v = (const float*)d_in[12]; p.cmp_w2_v = (const float*)d_in[13];
  p.mla_q_g = (const float*)d_in[14]; p.mla_w_uq = (const float*)d_in[15]; p.mla_kv_g = (const float*)d_in[16]; p.mla_w_ukv = (const float*)d_in[17];
  p.w_o = (const float*)d_in[18]; p.norm_ffn_g = (const float*)d_in[19]; p.w_gate = (const float*)d_in[20]; p.w_up = (const float*)d_in[21];
  p.conv_w = (const float*)d_in[22]; p.conv_b = (const float*)d_in[23]; p.w_down = (const float*)d_in[24]; p.final_g = (const float*)d_in[25];
  p.out = (float*)d_out; p.ws = (unsigned char*)d_ws;
#if N_LAUNCH_MODE == 0
  static int grid_blocks = 0;
  if (!grid_blocks) {
    int dev = 0, cus = 0, per_cu = 0;
    (void)hipGetDevice(&dev);
    (void)hipDeviceGetAttribute(&cus, hipDeviceAttributeMultiprocessorCount, dev);
    (void)hipOccupancyMaxActiveBlocksPerMultiprocessor(&per_cu, mega_kernel, 256, 0);
    if (per_cu > 2) per_cu = 2;
    if (per_cu < 1) per_cu = 1;
    grid_blocks = cus * per_cu;
  }
  (void)hipMemsetAsync((unsigned char*)d_ws + OFF_BAR, 0, 16384, stream);
  void* args[] = {&p};
  hipError_t e = hipLaunchCooperativeKernel((void*)mega_kernel, dim3(grid_blocks), dim3(256), args, 0, stream);
  if (e != hipSuccess) fprintf(stderr, "cooperative launch failed: %s (grid %d)\n", hipGetErrorString(e), grid_blocks);
#else
  for (int ph = 0; ph < NPHASE; ++ph) phase_kernel<<<512, 256, 0, stream>>>(p, ph);
#endif
}
```

```cpp
#include <hip/hip_runtime.h>
#include <hip/hip_cooperative_groups.h>
#include <stdint.h>
#include <stdio.h>
namespace cg = cooperative_groups;

typedef unsigned short u16;
typedef short bf16x8 __attribute__((ext_vector_type(8)));
typedef short s16x4 __attribute__((ext_vector_type(4)));
typedef float f32x4 __attribute__((ext_vector_type(4)));
typedef unsigned u32x4 __attribute__((ext_vector_type(4)));
#define DI __device__ __forceinline__

#ifndef N_LAUNCH_MODE
#define N_LAUNCH_MODE 0
#endif

constexpr int Bn = 32, Sn = 2048, Dm = 1024, Tn = Bn * Sn;
constexpr int ZC = 5120;
constexpr int FF = 2816;
constexpr int NCMP = 127;
constexpr int CROWS = Bn * NCMP * 4;
constexpr float LOG2E = 1.4426950408889634f;

constexpr size_t OFF_WIN  = 0;
constexpr size_t OFF_WO   = OFF_WIN  + (size_t)ZC * 1024 * 2;
constexpr size_t OFF_WGU  = OFF_WO   + (size_t)1024 * 1024 * 2;
constexpr size_t OFF_WDN  = OFF_WGU  + (size_t)5632 * 1024 * 2;
constexpr size_t OFF_W1K  = OFF_WDN  + (size_t)1024 * FF * 2;
constexpr size_t OFF_W1V  = OFF_W1K  + (size_t)256 * 2048 * 2;
constexpr size_t OFF_W2K  = OFF_W1V  + (size_t)256 * 2048 * 2;
constexpr size_t OFF_W2V  = OFF_W2K  + (size_t)128 * 256 * 2;
constexpr size_t OFF_WUQ  = OFF_W2V  + (size_t)128 * 256 * 2;
constexpr size_t OFF_WUKV = OFF_WUQ  + (size_t)768 * 256 * 2;
constexpr size_t OFF_B1   = OFF_WUKV + (size_t)1536 * 128 * 2;
constexpr size_t OFF_MODP = OFF_B1   + (size_t)2 * 256 * 4;
constexpr size_t OFF_MOD  = OFF_MODP + (size_t)8 * 32 * 6144 * 4;
constexpr size_t OFF_KC   = OFF_MOD  + (size_t)32 * 6144 * 4;
constexpr size_t OFF_VC   = OFF_KC   + (size_t)Bn * 4 * 128 * 64 * 2;
constexpr size_t OFF_SELM = OFF_VC   + (size_t)Bn * 4 * 128 * 64 * 2;
constexpr size_t OFF_HID  = OFF_SELM + (size_t)Tn * 4 * 4;
constexpr size_t OFF_HBUF = OFF_HID  + (size_t)2 * CROWS * 256 * 2;
constexpr size_t OFF_Z    = OFF_HBUF + (size_t)Tn * 1024 * 2;
constexpr size_t OFF_QB   = OFF_Z;
constexpr size_t OFF_KVC  = OFF_QB   + (size_t)Tn * 1024 * 2;
constexpr size_t OFF_KVS  = OFF_KVC  + (size_t)Tn * 512 * 2;
constexpr size_t OFF_KVW  = OFF_KVS  + (size_t)Tn * 512 * 2;
constexpr size_t OFF_MQ   = OFF_KVW  + (size_t)Tn * 512 * 2;
constexpr size_t OFF_MKV  = OFF_MQ   + (size_t)Tn * 256 * 2;
constexpr size_t OFF_MA   = OFF_MKV  + (size_t)Tn * 256 * 2;
constexpr size_t OFF_MB   = OFF_MA   + (size_t)Tn * 1024 * 2;
constexpr size_t OFF_KVU  = OFF_MB   + (size_t)Tn * 1024 * 2;
constexpr size_t OFF_BAR  = OFF_KVU  + (size_t)Tn * 1536 * 2;
constexpr size_t WS_NEED  = OFF_BAR + 16384;
constexpr size_t OFF_QU   = OFF_HBUF;
constexpr size_t OFF_ACT  = OFF_Z;
constexpr size_t OFF_GSIDE = OFF_KVU;
constexpr size_t OFF_USIDE = OFF_GSIDE + (size_t)512 * 4 * FF * 4;
static_assert(OFF_ACT + (size_t)Tn * FF * 2 <= OFF_MKV, "ACT overlay");

struct Params {
  const float *x, *c; const int* pos; const float *rel, *ada_w, *ada_b, *norm_mix_g, *w_in,
      *cmp_pos_k, *cmp_w1_k, *cmp_w2_k, *cmp_pos_v, *cmp_w1_v, *cmp_w2_v, *mla_q_g, *mla_w_uq, *mla_kv_g, *mla_w_ukv,
      *w_o, *norm_ffn_g, *w_gate, *w_up, *conv_w, *conv_b, *w_down, *final_g;
  float* out; unsigned char* ws;
};

#define SMEM_BYTES 74240

DI int tidx() { int t = __builtin_amdgcn_workitem_id_x(); asm volatile("" : "+v"(t)); return t; }
typedef float f32x2_ __attribute__((ext_vector_type(2)));
typedef __bf16 bf16x2_ __attribute__((ext_vector_type(2)));
DI unsigned cvtpk(float lo, float hi) { const f32x2_ v = {lo, hi}; return __builtin_bit_cast(unsigned, __builtin_convertvector(v, bf16x2_)); }
DI float bf2f(u16 v) { return __uint_as_float(((unsigned)v) << 16); }
DI float bflo(unsigned w) { return __uint_as_float(w << 16); }
DI float bfhi(unsigned w) { return __uint_as_float(w & 0xffff0000u); }
DI float sigmoidf_(float x) { return 1.0f / (1.0f + __expf(-x)); }
DI void store4(u16* dst, f32x4 v) { uint2 w; w.x = cvtpk(v[0], v[1]); w.y = cvtpk(v[2], v[3]); *(uint2*)dst = w; }
DI f32x4 load4bf(const u16* src) { uint2 w = *(const uint2*)src; return (f32x4){bflo(w.x), bfhi(w.x), bflo(w.y), bfhi(w.y)}; }
DI float ex2(float x) { return __builtin_amdgcn_exp2f(x); }
DI f32x4 mfma16(bf16x8 a, bf16x8 b, f32x4 c) { return __builtin_amdgcn_mfma_f32_16x16x32_bf16(a, b, c, 0, 0, 0); }

DI int t5_bucket(int n) {
  if (n < 16) return n;
  int b = 16;
  b += (n >= 19); b += (n >= 21); b += (n >= 24); b += (n >= 27); b += (n >= 31); b += (n >= 35); b += (n >= 40); b += (n >= 46);
  b += (n >= 52); b += (n >= 59); b += (n >= 67); b += (n >= 77); b += (n >= 87); b += (n >= 99); b += (n >= 113);
  return b;
}

DI void rope_table(const int* __restrict__ pos, float* __restrict__ cs, int gtid, int gsz) {
  for (int e = gtid; e < Tn * 16; e += gsz) {
    const int t = e >> 4, i = e & 15;
    const float inv = exp2f(-(float)i * (13.287712379549449f / 16.0f));
    const float ang = (float)pos[t] * inv;
    const double rev = (double)ang * 0.15915494309189535;
    const float fr = (float)(rev - floor(rev));
    *(float2*)(cs + (size_t)e * 2) = make_float2(__builtin_amdgcn_cosf(fr), __builtin_amdgcn_sinf(fr));
  }
}
DI void rope4(f32x4& a, f32x4& b, const float* __restrict__ cs, int t, int lq) {
  const f32x4 c01 = *(const f32x4*)(cs + (size_t)t * 32 + lq * 8), c23 = *(const f32x4*)(cs + (size_t)t * 32 + lq * 8 + 4);
  const float cv[4] = {c01[0], c01[2], c23[0], c23[2]}, sv[4] = {c01[1], c01[3], c23[1], c23[3]};
#pragma unroll
  for (int j = 0; j < 4; ++j) {
    const float x1 = a[j], x2 = b[j];
    a[j] = x1 * cv[j] - x2 * sv[j];
    b[j] = x2 * cv[j] + x1 * sv[j];
  }
}

template <bool PARTIAL> DI float modval(const Params& p, int b, int n) {
  if (PARTIAL) {
    const float* mp = (const float*)(p.ws + OFF_MODP);
    float s = p.ada_b[n];
#pragma unroll
    for (int kc = 0; kc < 8; ++kc) s += mp[(size_t)(kc * 32 + b) * 6144 + n];
    return s;
  } else {
    return ((const float*)(p.ws + OFF_MOD))[(size_t)b * 6144 + n];
  }
}

DI int map_win(int n) {
  if (n < 2560) return n;
  if (n < 2816) return 2608 + (n - 2560);
  if (n < 2944) return 2864 + (n - 2816);
  if (n < 2976) return 2992 + (n - 2944);
  if (n < 3024) return 2560 + (n - 2976);
  if (n < 3072) return -1;
  if (n < 4096) return 3024 + (n - 3072);
  return 4048 + (n - 4096);
}

DI void conv_w(const float* __restrict__ src, const float* __restrict__ src2, int ld_src, u16* __restrict__ dst, int Ndst, int K,
               int mapid, const float* __restrict__ gain, int gtid, int gsz) {
  const int total = Ndst * (K >> 3);
  for (int it = gtid; it < total; it += gsz) {
    const int k8 = it / Ndst, n = it - k8 * Ndst;
    const float* s = src; int oc = n;
    if (mapid == 1) oc = map_win(n);
    else if (mapid == 2) { const int fb = n >> 7, r = n & 127, sb = r >> 4, i = r & 15; oc = fb * 64 + (sb >> 1) * 16 + i; s = (sb & 1) ? src2 : src; }
    else if (mapid == 3) oc = (n < 64) ? n : -1;
    else if (mapid == 4) { if (n < 512) oc = (n >> 6) * 96 + (n & 63); else { const int r = n - 512; oc = (r >> 5) * 96 + 64 + (r & 31); } }
    u32x4 w = {0u, 0u, 0u, 0u};
    if (oc >= 0) {
      float v[8];
#pragma unroll
      for (int i = 0; i < 8; ++i) { float g = gain ? gain[k8 * 8 + i] : 1.0f; v[i] = s[(size_t)(k8 * 8 + i) * ld_src + oc] * g; }
      w.x = cvtpk(v[0], v[1]); w.y = cvtpk(v[2], v[3]); w.z = cvtpk(v[4], v[5]); w.w = cvtpk(v[6], v[7]);
    }
    *(u32x4*)(dst + ((size_t)(k8 >> 2) * Ndst + n) * 32 + (k8 & 3) * 8) = w;
  }
}

DI void phase0(const Params& p, int bid, int nblk, unsigned char* smem) {
  const int tid = tidx();
  float* sc = (float*)smem;
  for (int item = bid; item < 194; item += nblk) {
    if (item < 192) {
      const int kc = item / 24, nb = item % 24, n = nb * 256 + tid;
      __syncthreads();
      for (int e = tid; e < 4096; e += 256) { const int b = e >> 7, kk = e & 127; const float v = p.c[b * 1024 + kc * 128 + kk]; sc[e] = v / (1.0f + __expf(-v)); }
      __syncthreads();
      float acc[32];
#pragma unroll
      for (int b = 0; b < 32; ++b) acc[b] = 0.f;
#pragma unroll 4
      for (int kk = 0; kk < 128; ++kk) {
        const float w = p.ada_w[(size_t)(kc * 128 + kk) * 6144 + n];
#pragma unroll
        for (int b = 0; b < 32; ++b) acc[b] += sc[b * 128 + kk] * w;
      }
      float* mp = (float*)(p.ws + OFF_MODP);
#pragma unroll
      for (int b = 0; b < 32; ++b) mp[(size_t)(kc * 32 + b) * 6144 + n] = acc[b];
    } else {
      const int kv = item - 192;
      const float* pos = kv ? p.cmp_pos_v : p.cmp_pos_k;
      const float* w1 = kv ? p.cmp_w1_v : p.cmp_w1_k;
      float s = 0.f;
#pragma unroll 16
      for (int k = 0; k < 2048; ++k) s += pos[k] * w1[(size_t)k * 256 + tid];
      ((float*)(p.ws + OFF_B1))[kv * 256 + tid] = s;
    }
  }
  const int gtid = bid * 256 + tid, gsz = nblk * 256;
  conv_w(p.w_in, nullptr, 5072, (u16*)(p.ws + OFF_WIN), ZC, 1024, 1, nullptr, gtid, gsz);
  conv_w(p.w_o, nullptr, 1024, (u16*)(p.ws + OFF_WO), 1024, 1024, 0, nullptr, gtid, gsz);
  conv_w(p.w_gate, p.w_up, FF, (u16*)(p.ws + OFF_WGU), 5632, 1024, 2, nullptr, gtid, gsz);
  conv_w(p.w_down, nullptr, 1024, (u16*)(p.ws + OFF_WDN), 1024, FF, 0, nullptr, gtid, gsz);
  conv_w(p.cmp_w1_k, nullptr, 256, (u16*)(p.ws + OFF_W1K), 256, 2048, 0, nullptr, gtid, gsz);
  conv_w(p.cmp_w1_v, nullptr, 256, (u16*)(p.ws + OFF_W1V), 256, 2048, 0, nullptr, gtid, gsz);
  conv_w(p.cmp_w2_k, nullptr, 64, (u16*)(p.ws + OFF_W2K), 128, 256, 3, nullptr, gtid, gsz);
  conv_w(p.cmp_w2_v, nullptr, 64, (u16*)(p.ws + OFF_W2V), 128, 256, 3, nullptr, gtid, gsz);
  conv_w(p.mla_w_uq, nullptr, 768, (u16*)(p.ws + OFF_WUQ), 768, 256, 4, p.mla_q_g, gtid, gsz);
  conv_w(p.mla_w_ukv, nullptr, 1536, (u16*)(p.ws + OFF_WUKV), 1536, 128, 0, p.mla_kv_g, gtid, gsz);
  for (int i = gtid; i < Bn * 4 * 64; i += gsz) {
    const int bg = i >> 6, d = i & 63;
    ((u16*)(p.ws + OFF_KC))[((size_t)bg * 128 + 127) * 64 + d] = 0;
    ((u16*)(p.ws + OFF_VC))[((size_t)bg * 128 + 127) * 64 + d] = 0;
  }
}

template <bool FIRST> DI void norm_pass(const Params& p, const float* __restrict__ src, const u16* __restrict__ srcb, const float* __restrict__ g, int shift_off, int scale_off,
                                        int bid, int nblk, unsigned char* smem) {
  const int tid = tidx(), lane = tid & 63, wave = tid >> 6;
  float* gs = (float*)smem; float* sh = gs + 1024;
  u16* dst = (u16*)(p.ws + OFF_HBUF);
  if (FIRST) {
    float* mod = (float*)(p.ws + OFF_MOD);
    for (int i = bid * 256 + tid; i < 32 * 6144; i += nblk * 256) mod[i] = modval<true>(p, i / 6144, i % 6144);
    rope_table(p.pos, p.out, bid * 256 + tid, nblk * 256);
  }
  for (int item = bid; item < 512; item += nblk) {
    const int b = item >> 4;
    __syncthreads();
    for (int k = tid; k < 1024; k += 256) {
      gs[k] = g[k] * (1.0f + modval<FIRST>(p, b, scale_off + k));
      sh[k] = modval<FIRST>(p, b, shift_off + k);
    }
    __syncthreads();
    auto ldrow = [&](float4 (&d)[4], size_t row) {
#pragma unroll
      for (int i = 0; i < 4; ++i) {
        if (FIRST) d[i] = ((const float4*)(src + row * 1024))[lane + 64 * i];
        else { const f32x4 q = load4bf(srcb + row * 1024 + (lane + 64 * i) * 4); d[i] = make_float4(q[0], q[1], q[2], q[3]); }
      }
    };
    const size_t row0 = (size_t)item * 128 + wave * 32;
    float4 v[4], nv[4];
    ldrow(v, row0);
    for (int r = 0; r < 32; ++r) {
      const size_t row = row0 + r;
      if (r + 1 < 32) ldrow(nv, row + 1);
      float ss = 0.f;
#pragma unroll
      for (int i = 0; i < 4; ++i) ss += v[i].x * v[i].x + v[i].y * v[i].y + v[i].z * v[i].z + v[i].w * v[i].w;
#pragma unroll
      for (int o = 32; o >= 1; o >>= 1) ss += __shfl_xor(ss, o);
      const float rstd = rsqrtf(ss * (1.0f / 1024.0f) + 1e-6f);
#pragma unroll
      for (int i = 0; i < 4; ++i) {
        const int k = (lane + 64 * i) * 4;
        const float4 gg = *(const float4*)(gs + k), hh = *(const float4*)(sh + k);
        f32x4 o = {v[i].x * rstd * gg.x + hh.x, v[i].y * rstd * gg.y + hh.y, v[i].z * rstd * gg.z + hh.z, v[i].w * rstd * gg.w + hh.w};
        store4(dst + ((size_t)(k >> 5) * Tn + row) * 32 + (k & 31), o);
      }
#pragma unroll
      for (int i = 0; i < 4; ++i) v[i] = nv[i];
    }
  }
}

template <int NI, class XL, class EP>
DI void gemm_tile(const u16* __restrict__ W, int ldw, int f0, int t0, int K, XL xl, EP ep, unsigned char* smem) {
  constexpr int LST = 48;
  constexpr int XR = NI / 2;
  constexpr int BUF = (128 + NI * 32) * LST;
  u16* S0 = (u16*)smem;
  const int tid = tidx(), lane = tid & 63, wave = tid >> 6;
  const int wf = wave >> 1, wt = wave & 1, lr = lane & 15, lq = lane >> 4;
  const int srow = tid >> 2, sch = (tid & 3) * 8;
  f32x4 acc[4][NI];
#pragma unroll
  for (int i = 0; i < 4; ++i)
#pragma unroll
    for (int j = 0; j < NI; ++j) acc[i][j] = (f32x4){0.f, 0.f, 0.f, 0.f};
  u32x4 wr[2], xr[XR];
  const unsigned wbyte = ((unsigned)(f0 + srow * 2) * 32u + sch) * 2u;
  const unsigned xbyte = xl.rowoff(t0 + srow * XR, sch) * 2u;
  const int xrs = xl.rstride();
  const int nk = K >> 5;
  auto gload = [&](int it) {
    const int k = it * 32;
    const char* wb = (const char*)(W + (size_t)(k >> 5) * ldw * 32);
    const char* xb = (const char*)xl.kbase(k);
#pragma unroll
    for (int i = 0; i < 2; ++i) wr[i] = *(const u32x4*)(wb + wbyte + i * 64);
#pragma unroll
    for (int i = 0; i < XR; ++i) xr[i] = *(const u32x4*)(xb + xbyte + i * xrs);
  };
  auto lstore = [&](int buf) {
    u16* Ws = S0 + buf * BUF; u16* Xs = Ws + 128 * LST;
#pragma unroll
    for (int i = 0; i < 2; ++i) *(u32x4*)(Ws + (srow * 2 + i) * LST + sch) = wr[i];
#pragma unroll
    for (int i = 0; i < XR; ++i) *(u32x4*)(Xs + (srow * XR + i) * LST + sch) = xr[i];
  };
  gload(0);
  __syncthreads();
  lstore(0);
  __syncthreads();
  if (nk > 1) gload(1);
  for (int it = 0; it < nk; ++it) {
    const u16* Ws = S0 + (it & 1) * BUF; const u16* Xs = Ws + 128 * LST;
    __builtin_amdgcn_s_setprio(1);
    bf16x8 a[4];
#pragma unroll
    for (int mi = 0; mi < 4; ++mi) a[mi] = *(const bf16x8*)(Ws + (wf * 64 + mi * 16 + lr) * LST + lq * 8);
#pragma unroll
    for (int ni = 0; ni < NI; ++ni) {
      const bf16x8 b = *(const bf16x8*)(Xs + (wt * (NI * 16) + ni * 16 + lr) * LST + lq * 8);
#pragma unroll
      for (int mi = 0; mi < 4; ++mi) acc[mi][ni] = mfma16(a[mi], b, acc[mi][ni]);
    }
    __builtin_amdgcn_sched_group_barrier(0x100, 6, 0);
#pragma unroll
    for (int ni = 0; ni < NI; ++ni) { __builtin_amdgcn_sched_group_barrier(0x008, 4, 0); if (ni + 2 < NI) __builtin_amdgcn_sched_group_barrier(0x100, 1, 0); }
    __builtin_amdgcn_s_setprio(0);
    if (it + 1 < nk) lstore((it + 1) & 1);
    if (it + 2 < nk) gload(it + 2);
    __syncthreads();
  }
  ep(acc, f0 + wf * 64, t0 + wt * (NI * 16), lr, lq, wf, wt);
}

template <class XL, class EP>
DI void gemm_tile_k128(const u16* __restrict__ W, int ldw, int f0, int t0, int K, XL xl, EP ep, unsigned char* smem) {
  constexpr int LST = 144;
  u16* Ws = (u16*)smem; u16* Xs = Ws + 128 * LST;
  const int tid = tidx(), lane = tid & 63, wave = tid >> 6;
  const int wf = wave >> 1, wt = wave & 1, lr = lane & 15, lq = lane >> 4;
  const int srow = tid >> 4, sch = (tid & 15) * 8;
  f32x4 acc[4][4];
#pragma unroll
  for (int i = 0; i < 4; ++i)
#pragma unroll
    for (int j = 0; j < 4; ++j) acc[i][j] = (f32x4){0.f, 0.f, 0.f, 0.f};
  const unsigned wbyte = (((unsigned)(sch >> 5) * ldw + f0 + srow * 8) * 32u + (sch & 31)) * 2u;
  const unsigned xbyte = xl.rowoff(t0 + srow * 8, sch) * 2u;
  const int xrs = xl.rstride();
  for (int kb = 0; kb < K; kb += 128) {
    u32x4 wr[8], xr[8];
    const char* wb = (const char*)(W + (size_t)(kb >> 5) * ldw * 32);
    const char* xb = (const char*)xl.kbase(kb);
#pragma unroll
    for (int i = 0; i < 8; ++i) { wr[i] = *(const u32x4*)(wb + wbyte + i * 64); xr[i] = *(const u32x4*)(xb + xbyte + i * xrs); }
    __syncthreads();
#pragma unroll
    for (int i = 0; i < 8; ++i) { *(u32x4*)(Ws + (srow * 8 + i) * LST + sch) = wr[i]; *(u32x4*)(Xs + (srow * 8 + i) * LST + sch) = xr[i]; }
    __syncthreads();
    __builtin_amdgcn_s_setprio(1);
#pragma unroll
    for (int ks = 0; ks < 4; ++ks) {
      bf16x8 a[4];
#pragma unroll
      for (int mi = 0; mi < 4; ++mi) a[mi] = *(const bf16x8*)(Ws + (wf * 64 + mi * 16 + lr) * LST + ks * 32 + lq * 8);
#pragma unroll
      for (int ni = 0; ni < 4; ++ni) {
        const bf16x8 b = *(const bf16x8*)(Xs + (wt * 64 + ni * 16 + lr) * LST + ks * 32 + lq * 8);
#pragma unroll
        for (int mi = 0; mi < 4; ++mi) acc[mi][ni] = mfma16(a[mi], b, acc[mi][ni]);
      }
    }
    __builtin_amdgcn_s_setprio(0);
  }
  ep(acc, f0 + wf * 64, t0 + wt * 64, lr, lq, wf, wt);
}

struct Sched { int xd, rank, nloc, nx; };
template <class F> DI void for_tiles_st(int ntm, int ntn, const Sched& sc, F f) {
  if ((ntn & 7) == 0) {
    const int nsn = ntn >> 3, nsuper = (ntm >> 3) * nsn;
    for (int sp = sc.xd; sp < nsuper; sp += sc.nx) {
      const int sm = sp / nsn, sn = sp - sm * nsn;
      for (int qq = sc.rank; qq < 64; qq += sc.nloc) f(sm * 8 + (qq >> 3), sn * 8 + (qq & 7));
    }
  } else {
    const int nsn = ntn >> 2, nsuper = (ntm >> 4) * nsn;
    for (int sp = sc.xd; sp < nsuper; sp += sc.nx) {
      const int sm = sp / nsn, sn = sp - sm * nsn;
      for (int qq = sc.rank; qq < 64; qq += sc.nloc) f(sm * 16 + (qq >> 2), sn * 4 + (qq & 3));
    }
  }
}

DI int tile_id(int i, int bid, int nblk) { const int per = nblk >> 3; return i * nblk + (bid & 7) * per + (bid >> 3); }

struct XBlk { const u16* X; int T; DI const u16* kbase(int k) const { return X + (size_t)(k >> 5) * T * 32; } DI unsigned rowoff(int t, int sch) const { return (unsigned)t * 32u + sch; } DI int rstride() const { return 64; } };
struct XPlain { const u16* X; int ld; DI const u16* kbase(int k) const { return X + k; } DI unsigned rowoff(int t, int sch) const { return (unsigned)t * (unsigned)ld + sch; } DI int rstride() const { return ld * 2; } };

DI void row_rstd(const u16* X, int ld, int K, int t0, float* rs) {
  const int r = tidx() & 127;
  const u16* xp = X + (size_t)(t0 + r) * ld;
  float ss = 0.f;
  for (int k = 0; k < K; k += 8) {
    const u32x4 w = *(const u32x4*)(xp + k);
    const float a0 = bflo(w.x), a1 = bfhi(w.x), a2 = bflo(w.y), a3 = bfhi(w.y), a4 = bflo(w.z), a5 = bfhi(w.z), a6 = bflo(w.w), a7 = bfhi(w.w);
    ss += a0 * a0 + a1 * a1 + a2 * a2 + a3 * a3 + a4 * a4 + a5 * a5 + a6 * a6 + a7 * a7;
  }
  rs[r] = rsqrtf(ss / (float)K + 1e-6f);
}

DI void phase1(const Params& p, const Sched& sched, unsigned char* smem) {
  const u16* W = (const u16*)(p.ws + OFF_WIN);
  XBlk xl{(const u16*)(p.ws + OFF_HBUF), Tn};
  for_tiles_st(256, ZC / 128, sched, [&](int tm, int tn) {
    const int f0 = tn * 128, t0 = tm * 256;
    gemm_tile<8>(W, ZC, f0, t0, 1024, xl, [&](f32x4 (&acc)[4][8], int fb, int tb, int lr, int lq, int wf, int wt) {
      u16* dst; int ld, cb;
      if (tn < 8) { dst = (u16*)(p.ws + OFF_QB); ld = 1024; cb = 0; }
      else if (tn < 12) { dst = (u16*)(p.ws + OFF_KVC); ld = 512; cb = 1024; }
      else if (tn < 16) { dst = (u16*)(p.ws + OFF_KVS); ld = 512; cb = 1536; }
      else if (tn < 20) { dst = (u16*)(p.ws + OFF_KVW); ld = 512; cb = 2048; }
      else if (tn < 22) { dst = (u16*)(p.ws + OFF_MQ); ld = 256; cb = 2560; }
      else if (tn < 24) { dst = (u16*)(p.ws + OFF_MKV); ld = 256; cb = 2816; }
      else if (tn < 32) { dst = (u16*)(p.ws + OFF_MA); ld = 1024; cb = 3072; }
      else { dst = (u16*)(p.ws + OFF_MB); ld = 1024; cb = 4096; }
      if (tn == 23 && wf == 0) {
#pragma unroll
        for (int ni = 0; ni < 8; ++ni) { const int t = tb + ni * 16 + lr; rope4(acc[0][ni], acc[1][ni], p.out, t, lq); }
      }
      constexpr int EST = 136;
      u16* Ls = (u16*)smem;
      __syncthreads();
#pragma unroll
      for (int mi = 0; mi < 4; ++mi)
#pragma unroll
        for (int ni = 0; ni < 8; ++ni) store4(Ls + (wt * 128 + ni * 16 + lr) * EST + wf * 64 + mi * 16 + lq * 4, acc[mi][ni]);
      __syncthreads();
      const int tid = tidx();
#pragma unroll
      for (int i = 0; i < 16; ++i) {
        const int c = tid + 256 * i, row = c >> 4, ch = (c & 15) * 8;
        *(u32x4*)(dst + (size_t)(t0 + row) * ld + (f0 - cb) + ch) = *(const u32x4*)(Ls + row * EST + ch);
      }
    }, smem);
  });
}

DI void epi_store128(const f32x4 (&acc)[4][4], unsigned char* smem, u16* dst, int ld, int wf, int wt, int lr, int lq) {
  constexpr int EST = 136;
  u16* Ls = (u16*)smem;
  __syncthreads();
#pragma unroll
  for (int mi = 0; mi < 4; ++mi)
#pragma unroll
    for (int ni = 0; ni < 4; ++ni) store4(Ls + (wt * 64 + ni * 16 + lr) * EST + wf * 64 + mi * 16 + lq * 4, acc[mi][ni]);
  __syncthreads();
  const int tid = tidx();
#pragma unroll
  for (int i = 0; i < 8; ++i) {
    const int c = tid + 256 * i, row = c >> 4, ch = (c & 15) * 8;
    *(u32x4*)(dst + (size_t)row * ld + ch) = *(const u32x4*)(Ls + row * EST + ch);
  }
}

struct XCmp { const u16* kvc; int off;
  DI const u16* kbase(int k) const { return kvc + (size_t)(k >> 6) * 512 + off + (k & 32); }
  DI unsigned rowoff(int r, int sch) const { const int g = r & 3, bc = r >> 2, b = bc / NCMP, c = bc - b * NCMP; return (unsigned)(b * Sn + c * 16) * 512u + g * 64 + sch; }
  DI int rstride() const { return 128; } };

DI void phase2(const Params& p, int bid, int nblk, unsigned char* smem) {
  float* rs = (float*)(smem + 73728);
  const int n_c1 = 2 * 127 * 2, n_kvu = 512 * 12, n_qu = 512 * 6, ntot = n_c1 + n_kvu + n_qu;
  for (int i = 0;; ++i) {
    const int tile = tile_id(i, bid, nblk); if (tile >= ntot) break;
    if (tile < n_c1) {
      const int kv = tile / 254, r = tile % 254, tm = r >> 1, tn = r & 1;
      const u16* W = (const u16*)(p.ws + (kv ? OFF_W1V : OFF_W1K));
      XCmp xl{(const u16*)(p.ws + OFF_KVC), kv * 256};
      const float* b1 = (const float*)(p.ws + OFF_B1) + kv * 256;
      u16* hid = (u16*)(p.ws + OFF_HID) + (size_t)kv * CROWS * 256;
      gemm_tile<4>(W, 256, tn * 128, tm * 128, 2048, xl, [&](f32x4 (&acc)[4][4], int fb, int tb, int lr, int lq, int wf, int wt) {
#pragma unroll
        for (int mi = 0; mi < 4; ++mi) {
          const int f = fb + mi * 16 + lq * 4; const float4 bb = *(const float4*)(b1 + f);
#pragma unroll
          for (int ni = 0; ni < 4; ++ni) {
            const int t = tb + ni * 16 + lr; f32x4 v = acc[mi][ni]; v[0] += bb.x; v[1] += bb.y; v[2] += bb.z; v[3] += bb.w;
#pragma unroll
            for (int j = 0; j < 4; ++j) { const float xx = v[j]; const float u = 0.7978845608028654f * (xx + 0.044715f * xx * xx * xx); const float th = 1.0f - 2.0f / (__expf(2.0f * u) + 1.0f); v[j] = 0.5f * xx * (1.0f + th); }
            store4(hid + ((size_t)(f >> 5) * CROWS + t) * 32 + (f & 31), v);
          }
        }
      }, smem);
    } else if (tile < n_c1 + n_kvu) {
      const int r = tile - n_c1, tm = r / 12, tn = r % 12, t0 = tm * 128;
      const u16* X = (const u16*)(p.ws + OFF_MKV);
      __syncthreads();
      row_rstd(X, 256, 128, t0, rs);
      XPlain xl{X, 256};
      u16* kvu = (u16*)(p.ws + OFF_KVU);
      gemm_tile_k128((const u16*)(p.ws + OFF_WUKV), 1536, tn * 128, t0, 128, xl, [&](f32x4 (&acc)[4][4], int fb, int tb, int lr, int lq, int wf, int wt) {
#pragma unroll
        for (int ni = 0; ni < 4; ++ni) {
          const int t = tb + ni * 16 + lr; const float sc = rs[t - t0];
#pragma unroll
          for (int mi = 0; mi < 4; ++mi) acc[mi][ni] = acc[mi][ni] * sc;
        }
        epi_store128(acc, smem, kvu + (size_t)t0 * 1536 + tn * 128, 1536, wf, wt, lr, lq);
      }, smem);
    } else {
      const int r = tile - n_c1 - n_kvu, tm = r / 6, tn = r % 6, t0 = tm * 128;
      const u16* X = (const u16*)(p.ws + OFF_MQ);
      __syncthreads();
      row_rstd(X, 256, 256, t0, rs);
      XPlain xl{X, 256};
      u16* qu = (u16*)(p.ws + OFF_QU);
      gemm_tile_k128((const u16*)(p.ws + OFF_WUQ), 768, tn * 128, t0, 256, xl, [&](f32x4 (&acc)[4][4], int fb, int tb, int lr, int lq, int wf, int wt) {
#pragma unroll
        for (int ni = 0; ni < 4; ++ni) {
          const int t = tb + ni * 16 + lr; const float sc = rs[t - t0];
#pragma unroll
          for (int mi = 0; mi < 4; ++mi) acc[mi][ni] = acc[mi][ni] * sc;
          if (tn >= 4) { rope4(acc[0][ni], acc[1][ni], p.out, t, lq); rope4(acc[2][ni], acc[3][ni], p.out, t, lq); }
        }
        epi_store128(acc, smem, qu + (size_t)t0 * 768 + tn * 128, 768, wf, wt, lr, lq);
      }, smem);
    }
  }
}

template <int VSTB> DI void tr8(unsigned addr, s16x4 (&lo)[4], s16x4 (&hi)[4]) {
  asm volatile(
      "ds_read_b64_tr_b16 %0, %8\n\t"
      "ds_read_b64_tr_b16 %1, %8 offset:%9\n\t"
      "ds_read_b64_tr_b16 %2, %8 offset:32\n\t"
      "ds_read_b64_tr_b16 %3, %8 offset:%10\n\t"
      "ds_read_b64_tr_b16 %4, %8 offset:64\n\t"
      "ds_read_b64_tr_b16 %5, %8 offset:%11\n\t"
      "ds_read_b64_tr_b16 %6, %8 offset:96\n\t"
      "ds_read_b64_tr_b16 %7, %8 offset:%12\n\t"
      "s_waitcnt lgkmcnt(0)"
      : "=&v"(lo[0]), "=&v"(hi[0]), "=&v"(lo[1]), "=&v"(hi[1]), "=&v"(lo[2]), "=&v"(hi[2]), "=&v"(lo[3]), "=&v"(hi[3])
      : "v"(addr), "i"(16 * VSTB), "i"(16 * VSTB + 32), "i"(16 * VSTB + 64), "i"(16 * VSTB + 96)
      : "memory");
}

template <int NT, int VST> DI void pv32(f32x4 (&O)[4][NT], const u16* Vs, int krow, int dcol, const bf16x8 (&pb)[NT], int lr, int lq) {
  const unsigned addr = (unsigned)(size_t)(Vs + (krow + 4 * lq + (lr >> 2)) * VST + dcol + 4 * (lr & 3));
  s16x4 lo[4], hi[4];
  tr8<VST * 2>(addr, lo, hi);
#pragma unroll
  for (int dt = 0; dt < 4; ++dt) {
    const bf16x8 a = __builtin_shufflevector(lo[dt], hi[dt], 0, 1, 2, 3, 4, 5, 6, 7);
#pragma unroll
    for (int nt = 0; nt < NT; ++nt) O[dt][nt] = mfma16(a, pb[nt], O[dt][nt]);
  }
}

DI bf16x8 pack8(f32x4 a, f32x4 b) {
  union { unsigned u[4]; bf16x8 v; } r;
  r.u[0] = cvtpk(a[0], a[1]); r.u[1] = cvtpk(a[2], a[3]); r.u[2] = cvtpk(b[0], b[1]); r.u[3] = cvtpk(b[2], b[3]);
  return r.v;
}

template <int NT, class F> DI void softmax_step(f32x4 (&S)[4][NT], float (&m)[NT], float (&l)[NT], float (&alpha)[NT], bf16x8 (&pb)[2][NT], F f) {
#pragma unroll
  for (int nt = 0; nt < NT; ++nt) {
    float mx = -1e30f;
#pragma unroll
    for (int mt = 0; mt < 4; ++mt)
#pragma unroll
      for (int j = 0; j < 4; ++j) { const float s2 = f(mt, j, nt, S[mt][nt][j]); S[mt][nt][j] = s2; mx = fmaxf(mx, s2); }
    mx = fmaxf(mx, __shfl_xor(mx, 16)); mx = fmaxf(mx, __shfl_xor(mx, 32));
    const float mn = (mx > m[nt] + 8.0f) ? mx : m[nt];
    alpha[nt] = ex2(m[nt] - mn); m[nt] = mn;
    const float mexp = (mn < -1e29f) ? 0.f : mn;
    float sum = 0.f;
#pragma unroll
    for (int mt = 0; mt < 4; ++mt)
#pragma unroll
      for (int j = 0; j < 4; ++j) { const float pv = ex2(S[mt][nt][j] - mexp); sum += pv; S[mt][nt][j] = pv; }
    l[nt] = l[nt] * alpha[nt] + sum;
    pb[0][nt] = pack8(S[0][nt], S[1][nt]);
    pb[1][nt] = pack8(S[2][nt], S[3][nt]);
  }
}

template <int NT> DI void softmax_fast(f32x4 (&S)[4][NT], float (&m)[NT], float (&l)[NT], float (&alpha)[NT], bf16x8 (&pb)[2][NT], float sc2, const float (&bias)[NT]) {
#pragma unroll
  for (int nt = 0; nt < NT; ++nt) {
    float mxr = S[0][nt][0];
#pragma unroll
    for (int mt = 0; mt < 4; ++mt)
#pragma unroll
      for (int j = 0; j < 4; ++j) mxr = fmaxf(mxr, S[mt][nt][j]);
    mxr = fmaxf(mxr, __shfl_xor(mxr, 16)); mxr = fmaxf(mxr, __shfl_xor(mxr, 32));
    const float mx = (bias[nt] > -1e29f) ? (mxr * sc2 + bias[nt]) : -1e30f;
    const float mn = (mx > m[nt] + 8.0f) ? mx : m[nt];
    alpha[nt] = ex2(m[nt] - mn); m[nt] = mn;
    const float c = bias[nt] - ((mn < -1e29f) ? 0.f : mn);
    float sum = 0.f;
#pragma unroll
    for (int mt = 0; mt < 4; ++mt)
#pragma unroll
      for (int j = 0; j < 4; ++j) { const float pv = ex2(S[mt][nt][j] * sc2 + c); sum += pv; S[mt][nt][j] = pv; }
    l[nt] = l[nt] * alpha[nt] + sum;
    pb[0][nt] = pack8(S[0][nt], S[1][nt]);
    pb[1][nt] = pack8(S[2][nt], S[3][nt]);
  }
}

DI void mla_item(const Params& p, int it, unsigned char* smem, u16* mb_out) {
  const int tid = tidx(), lane = tid & 63, wave = tid >> 6, lr = lane & 15, lq = lane >> 4;
  const int k = it >> 9, r = it & 511, cls = r >> 8, bh = r & 255, b = bh >> 3, hp = bh & 7;
  const int pi = k >> 1, qt = (k & 1) ? (2 * pi + cls) : (15 - 2 * pi - cls);
  const int q0 = qt * 128;
  constexpr int KST = 112, VST = 144;
  u16* Ks = (u16*)smem; u16* Vs = Ks + 64 * KST;
  const u16* kvu = (const u16*)(p.ws + OFF_KVU); const u16* mkv = (const u16*)(p.ws + OFF_MKV); const u16* qu = (const u16*)(p.ws + OFF_QU);
  const size_t tb0 = (size_t)b * Sn;
  bf16x8 qf[2][3];
#pragma unroll
  for (int nt = 0; nt < 2; ++nt) {
    const size_t t = tb0 + q0 + wave * 32 + nt * 16 + lr;
    qf[nt][0] = *(const bf16x8*)(qu + t * 768 + hp * 64 + lq * 8);
    qf[nt][1] = *(const bf16x8*)(qu + t * 768 + hp * 64 + 32 + lq * 8);
    qf[nt][2] = *(const bf16x8*)(qu + t * 768 + 512 + hp * 32 + lq * 8);
  }
  f32x4 Oa[4][2], Ob[4][2];
#pragma unroll
  for (int i = 0; i < 4; ++i) { Oa[i][0] = (f32x4){0.f, 0.f, 0.f, 0.f}; Oa[i][1] = (f32x4){0.f, 0.f, 0.f, 0.f}; Ob[i][0] = (f32x4){0.f, 0.f, 0.f, 0.f}; Ob[i][1] = (f32x4){0.f, 0.f, 0.f, 0.f}; }
  float m[2] = {-1e30f, -1e30f}, l[2] = {0.f, 0.f};
  const float sc2 = 0.10206207261596577f * LOG2E;
  const int njt = q0 / 64 + 2;
  u32x4 kr[3], vr[4];
  auto ldtile = [&](int jt) {
#pragma unroll
    for (int i = 0; i < 3; ++i) { const int ch = tid + 256 * i, row = ch / 12, c = (ch % 12) * 8; const size_t t = tb0 + jt * 64 + row;
      kr[i] = (c < 64) ? *(const u32x4*)(kvu + t * 1536 + hp * 192 + c) : *(const u32x4*)(mkv + t * 256 + 128 + (c - 64)); }
#pragma unroll
    for (int i = 0; i < 4; ++i) { const int ch = tid + 256 * i, row = ch >> 4, c = (ch & 15) * 8; const size_t t = tb0 + jt * 64 + row;
      vr[i] = *(const u32x4*)(kvu + t * 1536 + hp * 192 + 64 + c); }
  };
  ldtile(0);
  const int qw0 = q0 + wave * 32;
  for (int jt = 0; jt < njt; ++jt) {
    __syncthreads();
#pragma unroll
    for (int i = 0; i < 3; ++i) { const int ch = tid + 256 * i, row = ch / 12, c = (ch % 12) * 8; *(u32x4*)(Ks + row * KST + c) = kr[i]; }
#pragma unroll
    for (int i = 0; i < 4; ++i) { const int ch = tid + 256 * i, row = ch >> 4, c = (ch & 15) * 8; *(u32x4*)(Vs + row * VST + c) = vr[i]; }
    __syncthreads();
    if (jt + 1 < njt) ldtile(jt + 1);
    const int k0 = jt * 64;
    if (k0 <= qw0 + 31) {
      f32x4 S[4][2];
#pragma unroll
      for (int mt = 0; mt < 4; ++mt) { S[mt][0] = (f32x4){0.f, 0.f, 0.f, 0.f}; S[mt][1] = (f32x4){0.f, 0.f, 0.f, 0.f}; }
      __builtin_amdgcn_s_setprio(1);
#pragma unroll
      for (int mt = 0; mt < 4; ++mt)
#pragma unroll
        for (int ks = 0; ks < 3; ++ks) {
          const bf16x8 a = *(const bf16x8*)(Ks + (mt * 16 + lr) * KST + ks * 32 + lq * 8);
          S[mt][0] = mfma16(a, qf[0][ks], S[mt][0]); S[mt][1] = mfma16(a, qf[1][ks], S[mt][1]);
        }
      __builtin_amdgcn_sched_group_barrier(0x100, 3, 0);
#pragma unroll
      for (int i = 0; i < 12; ++i) { __builtin_amdgcn_sched_group_barrier(0x008, 2, 0); if (i + 3 < 12) __builtin_amdgcn_sched_group_barrier(0x100, 1, 0); }
      __builtin_amdgcn_s_setprio(0);
      float alpha[2]; bf16x8 pb[2][2];
      if (k0 + 63 <= qw0) {
        const float zb[2] = {0.f, 0.f};
        softmax_fast<2>(S, m, l, alpha, pb, sc2, zb);
      } else {
        const int dq = qw0 + lr - k0 - lq * 4;
        softmax_step<2>(S, m, l, alpha, pb, [&](int mt, int j, int nt, float raw) {
          return ((dq + nt * 16) - (mt * 16 + j) >= 0) ? raw * sc2 : -1e30f;
        });
      }
      if (__any((alpha[0] != 1.0f) || (alpha[1] != 1.0f))) {
#pragma unroll
        for (int dt = 0; dt < 4; ++dt) { Oa[dt][0] = Oa[dt][0] * alpha[0]; Oa[dt][1] = Oa[dt][1] * alpha[1]; Ob[dt][0] = Ob[dt][0] * alpha[0]; Ob[dt][1] = Ob[dt][1] * alpha[1]; }
      }
      __builtin_amdgcn_s_setprio(1);
#pragma unroll
      for (int kk = 0; kk < 2; ++kk) {
        pv32<2, VST>(Oa, Vs, kk * 32, 0, pb[kk], lr, lq);
        pv32<2, VST>(Ob, Vs, kk * 32, 64, pb[kk], lr, lq);
      }
      __builtin_amdgcn_s_setprio(0);
    }
  }
  const u16* mb = (const u16*)(p.ws + OFF_MB);
#pragma unroll
  for (int nt = 0; nt < 2; ++nt) {
    float lt = l[nt]; lt += __shfl_xor(lt, 16); lt += __shfl_xor(lt, 32);
    const float inv = 1.0f / lt;
    const size_t t = tb0 + q0 + wave * 32 + nt * 16 + lr;
#pragma unroll
    for (int dt = 0; dt < 8; ++dt) {
      const size_t oidx = t * 1024 + hp * 128 + dt * 16 + lq * 4;
      const f32x4 gm = load4bf(mb + oidx);
      const f32x4 ov = (dt < 4) ? Oa[dt & 3][nt] : Ob[dt & 3][nt];
      f32x4 o;
#pragma unroll
      for (int j = 0; j < 4; ++j) o[j] = sigmoidf_(gm[j]) * ov[j] * inv;
      store4(mb_out + oidx, o);
    }
  }
}

DI void phase3(const Params& p, int bid, int nblk, unsigned char* smem, u16* mb_out) {
  for (int i = 0;; ++i) {
    const int tile = tile_id(i, bid, nblk); if (tile >= 254) break;
    const int kv = tile / 127, tm = tile % 127;
    XBlk xl{(const u16*)(p.ws + OFF_HID) + (size_t)kv * CROWS * 256, CROWS};
    u16* dst = (u16*)(p.ws + (kv ? OFF_VC : OFF_KC));
    gemm_tile<4>((const u16*)(p.ws + (kv ? OFF_W2V : OFF_W2K)), 128, 0, tm * 128, 256, xl, [&](f32x4 (&acc)[4][4], int fb, int tb, int lr, int lq, int wf, int wt) {
      if (wf == 0) {
#pragma unroll
        for (int ni = 0; ni < 4; ++ni) {
          const int r = tb + ni * 16 + lr, g = r & 3, bc = r >> 2, b = bc / NCMP, c = bc - b * NCMP;
#pragma unroll
          for (int mi = 0; mi < 4; ++mi) store4(dst + ((size_t)(b * 4 + g) * 128 + c) * 64 + mi * 16 + lq * 4, acc[mi][ni]);
        }
      }
    }, smem);
  }
  __syncthreads();
  for (int it = bid; it < 4096; it += nblk) { mla_item(p, it, smem, mb_out); __syncthreads(); }
}

DI void cmp_item(const Params& p, int it, unsigned char* smem) {
  const int tid = tidx(), lane = tid & 63, wave = tid >> 6, lr = lane & 15, lq = lane >> 4;
  const int b = it >> 7, g = (it >> 5) & 3, s0 = (it & 31) * 64;
  constexpr int KST = 80;
  u16* Ks = (u16*)smem; u16* Vs = Ks + 128 * KST;
  float* bt = (float*)(smem + 2 * 128 * KST * 2);
  float* scb = bt + 512;
  const u16* kc = (const u16*)(p.ws + OFF_KC) + (size_t)(b * 4 + g) * 128 * 64;
  const u16* vc = (const u16*)(p.ws + OFF_VC) + (size_t)(b * 4 + g) * 128 * 64;
  __syncthreads();
  for (int ch = tid; ch < 1024; ch += 256) { const int row = ch >> 3, c = (ch & 7) * 8;
    *(u32x4*)(Ks + row * KST + c) = *(const u32x4*)(kc + row * 64 + c);
    *(u32x4*)(Vs + row * KST + c) = *(const u32x4*)(vc + row * 64 + c); }
  for (int e = tid; e < 512; e += 256) { const int hh = e >> 7, d = e & 127; bt[e] = p.rel[t5_bucket(d) * 16 + g * 4 + hh] * LOG2E; }
  __syncthreads();
  const int tq = s0 + wave * 16 + lr;
  const size_t t = (size_t)b * Sn + tq;
  const u16* qb = (const u16*)(p.ws + OFF_QB); const u16* mkv = (const u16*)(p.ws + OFF_MKV);
  u16* abuf = (u16*)(p.ws + OFF_HBUF);
  const float sc2 = 0.125f * LOG2E;
  f32x4 Ps[8];
#pragma unroll
  for (int mt = 0; mt < 8; ++mt) Ps[mt] = (f32x4){0.f, 0.f, 0.f, 0.f};
#pragma unroll 1
  for (int hh = 0; hh < 4; ++hh) {
    const int h = g * 4 + hh;
    bf16x8 qf[2];
    qf[0] = *(const bf16x8*)(qb + t * 1024 + h * 64 + lq * 8);
    qf[1] = *(const bf16x8*)(qb + t * 1024 + h * 64 + 32 + lq * 8);
    f32x4 S[8];
    float mx = -1e30f;
#pragma unroll
    for (int mt = 0; mt < 8; ++mt) {
      f32x4 s = (f32x4){0.f, 0.f, 0.f, 0.f};
#pragma unroll
      for (int ks = 0; ks < 2; ++ks) { const bf16x8 a = *(const bf16x8*)(Ks + (mt * 16 + lr) * KST + ks * 32 + lq * 8); s = mfma16(a, qf[ks], s); }
      if ((s0 + wave * 16) - (mt * 256 + 271) >= 113) {
        const float bf = bt[hh * 128 + 127];
#pragma unroll
        for (int j = 0; j < 4; ++j) { const float s2 = s[j] * sc2 + bf; s[j] = s2; mx = fmaxf(mx, s2); }
      } else {
#pragma unroll
        for (int j = 0; j < 4; ++j) {
          const int c = mt * 16 + lq * 4 + j, dist = tq - (c * 16 + 31);
          const int di = dist < 0 ? 0 : (dist > 127 ? 127 : dist);
          const float s2 = (dist >= 0) ? (s[j] * sc2 + bt[hh * 128 + di]) : -1e30f;
          s[j] = s2; mx = fmaxf(mx, s2);
        }
      }
      S[mt] = s;
    }
    mx = fmaxf(mx, __shfl_xor(mx, 16)); mx = fmaxf(mx, __shfl_xor(mx, 32));
    float sum = 0.f;
#pragma unroll
    for (int mt = 0; mt < 8; ++mt)
#pragma unroll
      for (int j = 0; j < 4; ++j) { const float s2 = S[mt][j]; const float pv = (s2 > -1e29f) ? ex2(s2 - mx) : 0.f; S[mt][j] = pv; sum += pv; }
    sum += __shfl_xor(sum, 16); sum += __shfl_xor(sum, 32);
    const float inv = sum > 0.f ? 1.0f / sum : 0.f;
#pragma unroll
    for (int mt = 0; mt < 8; ++mt) { S[mt] = S[mt] * inv; Ps[mt] = Ps[mt] + S[mt]; }
    f32x4 O[4][1];
#pragma unroll
    for (int dt = 0; dt < 4; ++dt) O[dt][0] = (f32x4){0.f, 0.f, 0.f, 0.f};
    __builtin_amdgcn_s_setprio(1);
#pragma unroll
    for (int kk = 0; kk < 4; ++kk) { bf16x8 pb[1]; pb[0] = pack8(S[2 * kk], S[2 * kk + 1]); pv32<1, KST>(O, Vs, kk * 32, 0, pb, lr, lq); }
    __builtin_amdgcn_s_setprio(0);
    const float g0 = sigmoidf_(bf2f(mkv[t * 256 + 160 + h * 3 + 0]));
#pragma unroll
    for (int dt = 0; dt < 4; ++dt) store4(abuf + t * 1024 + h * 64 + dt * 16 + lq * 4, O[dt][0] * g0);
  }
  float own[8];
  {
    float up[8];
#pragma unroll
    for (int mt = 0; mt < 8; ++mt) up[mt] = __shfl(Ps[mt][3], (lane + 48) & 63);
#pragma unroll
    for (int mt = 0; mt < 8; ++mt) {
      const float prev = (lq >= 1) ? up[mt] : (mt >= 1 ? up[mt >= 1 ? mt - 1 : 0] : 0.f);
      own[mt] = Ps[mt][0] + Ps[mt][1] + Ps[mt][2] + 0.5f * Ps[mt][3] + 0.5f * prev;
    }
  }
  const int cur = tq >> 6;
  float* myrow = scb + (wave * 16 + lr) * 33;
#pragma unroll
  for (int mt = 0; mt < 8; ++mt) {
    const int jb = 4 * mt + lq;
    float v = own[mt];
    if (jb == 0 || jb == cur || jb == cur - 1) v = INFINITY; else if (jb > cur) v = -INFINITY;
    own[mt] = v; myrow[jb] = v;
  }
  __syncthreads();
  int rank[8];
#pragma unroll
  for (int mt = 0; mt < 8; ++mt) rank[mt] = 0;
#pragma unroll 4
  for (int i = 0; i < 32; ++i) {
    const float si = myrow[i];
#pragma unroll
    for (int mt = 0; mt < 8; ++mt) { const int jb = 4 * mt + lq; rank[mt] += (si > own[mt] || (si == own[mt] && i < jb)) ? 1 : 0; }
  }
  unsigned msk = 0;
#pragma unroll
  for (int mt = 0; mt < 8; ++mt) if (rank[mt] < 16) msk |= 1u << (4 * mt + lq);
  msk |= __shfl_xor(msk, 16); msk |= __shfl_xor(msk, 32);
  if (lq == 0) ((unsigned*)(p.ws + OFF_SELM))[t * 4 + g] = msk;
}

DI void phase4(const Params& p, int bid, int nblk, unsigned char* smem) {
  for (int it = bid; it < 4096; it += nblk) cmp_item(p, it, smem);
}

DI void selwin_item(const Params& p, int it, unsigned char* smem, u16* y_out) {
  const int tid = tidx(), lane = tid & 63, wave = tid >> 6, lr = lane & 15, lq = lane >> 4;
  const int k = it >> 9, r = it & 511, cls = r >> 7, bg = r & 127, b = bg >> 2, g = bg & 3;
  const int pi = k >> 1, lo_ = pi * 4 + cls, qt = (k & 1) ? lo_ : (63 - lo_);
  const int s0 = qt * 32, cur = s0 >> 6, h = g * 4 + wave;
  constexpr int KST = 80;
  u16* Ks = (u16*)smem; u16* Vs = Ks + 64 * KST;
  float* bt = (float*)(smem + 2 * 64 * KST * 2);
  const size_t tb0 = (size_t)b * Sn;
  const u16* qb = (const u16*)(p.ws + OFF_QB);
  __syncthreads();
  for (int e = tid; e < 512; e += 256) { const int hh = e >> 7, d = e & 127; bt[e] = p.rel[t5_bucket(d) * 16 + g * 4 + hh] * LOG2E; }
  bf16x8 qf[2][2]; unsigned mw[2];
#pragma unroll
  for (int nt = 0; nt < 2; ++nt) {
    const size_t t = tb0 + s0 + nt * 16 + lr;
    qf[nt][0] = *(const bf16x8*)(qb + t * 1024 + h * 64 + lq * 8);
    qf[nt][1] = *(const bf16x8*)(qb + t * 1024 + h * 64 + 32 + lq * 8);
    mw[nt] = ((const unsigned*)(p.ws + OFF_SELM))[t * 4 + g];
  }
  unsigned orm = mw[0] | mw[1];
  orm |= __shfl_xor(orm, 1); orm |= __shfl_xor(orm, 2); orm |= __shfl_xor(orm, 4); orm |= __shfl_xor(orm, 8);
  orm = __builtin_amdgcn_readfirstlane(orm);
  orm &= (cur >= 31) ? 0xffffffffu : ((2u << cur) - 1u);
  const float sc2 = 0.125f * LOG2E;
  const float* btw = bt + wave * 128;
  const float bfar = p.rel[31 * 16 + h] * LOG2E;
  u32x4 krA[2], vrA[2], krB[2], vrB[2];
  f32x4 Ores[4][2];
  for (int pass = 0; pass < 2; ++pass) {
    const u16* kvp = (const u16*)(p.ws + (pass ? OFF_KVW : OFF_KVS));
    unsigned rem;
    if (pass == 0) rem = orm;
    else { int jlo = (s0 - 511) >> 6; if (jlo < 0) jlo = 0; rem = ((cur >= 31) ? 0xffffffffu : ((2u << cur) - 1u)) & ~((1u << jlo) - 1u); }
    auto ldtile = [&](u32x4 (&kr)[2], u32x4 (&vr)[2], int j) {
#pragma unroll
      for (int i = 0; i < 2; ++i) { const int ch = tid + 256 * i, row = ch >> 3, c = (ch & 7) * 8; const size_t t = tb0 + j * 64 + row;
        kr[i] = *(const u32x4*)(kvp + t * 512 + g * 64 + c); vr[i] = *(const u32x4*)(kvp + t * 512 + 256 + g * 64 + c); }
    };
    auto pop = [&]() { if (!rem) return -1; const int j = __ffs(rem) - 1; rem &= rem - 1; return j; };
    f32x4 O[4][2];
#pragma unroll
    for (int i = 0; i < 4; ++i) { O[i][0] = (f32x4){0.f, 0.f, 0.f, 0.f}; O[i][1] = (f32x4){0.f, 0.f, 0.f, 0.f}; }
    float m[2] = {-1e30f, -1e30f}, l[2] = {0.f, 0.f};
    auto process = [&](u32x4 (&kr)[2], u32x4 (&vr)[2], int j, int jn) {
      __syncthreads();
#pragma unroll
      for (int i = 0; i < 2; ++i) { const int ch = tid + 256 * i, row = ch >> 3, c = (ch & 7) * 8; *(u32x4*)(Ks + row * KST + c) = kr[i]; *(u32x4*)(Vs + row * KST + c) = vr[i]; }
      __syncthreads();
      if (jn >= 0) ldtile(kr, vr, jn);
      const int k0 = j * 64;
      f32x4 S[4][2];
#pragma unroll
      for (int mt = 0; mt < 4; ++mt) { S[mt][0] = (f32x4){0.f, 0.f, 0.f, 0.f}; S[mt][1] = (f32x4){0.f, 0.f, 0.f, 0.f}; }
      __builtin_amdgcn_s_setprio(1);
#pragma unroll
      for (int mt = 0; mt < 4; ++mt)
#pragma unroll
        for (int ks = 0; ks < 2; ++ks) {
          const bf16x8 a = *(const bf16x8*)(Ks + (mt * 16 + lr) * KST + ks * 32 + lq * 8);
          S[mt][0] = mfma16(a, qf[0][ks], S[mt][0]); S[mt][1] = mfma16(a, qf[1][ks], S[mt][1]);
        }
      __builtin_amdgcn_sched_group_barrier(0x100, 3, 0);
#pragma unroll
      for (int i = 0; i < 8; ++i) { __builtin_amdgcn_sched_group_barrier(0x008, 2, 0); if (i + 3 < 8) __builtin_amdgcn_sched_group_barrier(0x100, 1, 0); }
      __builtin_amdgcn_s_setprio(0);
      float alpha[2]; bf16x8 pb[2][2];
      const bool far = (s0 - (k0 + 63)) >= 113;
      if (far && (pass == 0 || (s0 + 31 - k0) < 512)) {
        float bs[2];
#pragma unroll
        for (int nt = 0; nt < 2; ++nt) bs[nt] = (pass == 0 && !((mw[nt] >> j) & 1u)) ? -1e30f : bfar;
        softmax_fast<2>(S, m, l, alpha, pb, sc2, bs);
      } else {
        const int dq = s0 + lr - k0 - lq * 4;
        float cb[2];
#pragma unroll
        for (int nt = 0; nt < 2; ++nt) cb[nt] = (pass == 0 && !((mw[nt] >> j) & 1u)) ? -1e30f : 0.f;
        if (j == cur) {
          softmax_step<2>(S, m, l, alpha, pb, [&](int mt, int jj, int nt, float raw) {
            const int dist = (dq + nt * 16) - (mt * 16 + jj);
            const int di = dist < 0 ? 0 : dist;
            const float s2 = raw * sc2 + (btw[di] + cb[nt]);
            return dist >= 0 ? s2 : -1e30f;
          });
        } else if (far) {
          softmax_step<2>(S, m, l, alpha, pb, [&](int mt, int jj, int nt, float raw) {
            const int dist = (dq + nt * 16) - (mt * 16 + jj);
            return dist < 512 ? (raw * sc2 + bfar) : -1e30f;
          });
        } else {
          softmax_step<2>(S, m, l, alpha, pb, [&](int mt, int jj, int nt, float raw) {
            const int dist = (dq + nt * 16) - (mt * 16 + jj);
            const int di = dist > 127 ? 127 : dist;
            return raw * sc2 + (btw[di] + cb[nt]);
          });
        }
      }
      if (__any((alpha[0] != 1.0f) || (alpha[1] != 1.0f))) {
#pragma unroll
        for (int dt = 0; dt < 4; ++dt) { O[dt][0] = O[dt][0] * alpha[0]; O[dt][1] = O[dt][1] * alpha[1]; }
      }
      __builtin_amdgcn_s_setprio(1);
#pragma unroll
      for (int kk = 0; kk < 2; ++kk) pv32<2, KST>(O, Vs, kk * 32, 0, pb[kk], lr, lq);
      __builtin_amdgcn_s_setprio(0);
    };
    int ja = pop(), jb = pop();
    if (ja >= 0) ldtile(krA, vrA, ja);
    if (jb >= 0) ldtile(krB, vrB, jb);
    while (ja >= 0) {
      const int jc = pop();
      process(krA, vrA, ja, jc);
      if (jb < 0) break;
      const int jd = pop();
      process(krB, vrB, jb, jd);
      ja = jc; jb = jd;
    }
#pragma unroll
    for (int nt = 0; nt < 2; ++nt) {
      float lt = l[nt]; lt += __shfl_xor(lt, 16); lt += __shfl_xor(lt, 32);
      const size_t t = tb0 + s0 + nt * 16 + lr;
      const float gt = sigmoidf_(bf2f(((const u16*)(p.ws + OFF_MKV))[t * 256 + 160 + h * 3 + 1 + pass]));
      const float f = gt / lt;
#pragma unroll
      for (int dt = 0; dt < 4; ++dt) { if (pass == 0) Ores[dt][nt] = O[dt][nt] * f; else Ores[dt][nt] = Ores[dt][nt] + O[dt][nt] * f; }
    }
  }
  const u16* ma = (const u16*)(p.ws + OFF_MA); const u16* mbp = (const u16*)(p.ws + OFF_MB); const u16* ab = (const u16*)(p.ws + OFF_HBUF);
#pragma unroll
  for (int nt = 0; nt < 2; ++nt) {
    const size_t t = tb0 + s0 + nt * 16 + lr;
#pragma unroll
    for (int dt = 0; dt < 4; ++dt) {
      const size_t idx = t * 1024 + h * 64 + dt * 16 + lq * 4;
      const f32x4 a = load4bf(ab + idx), mav = load4bf(ma + idx), mbv = load4bf(mbp + idx);
      f32x4 y;
#pragma unroll
      for (int j = 0; j < 4; ++j) y[j] = sigmoidf_(mav[j]) * (a[j] + Ores[dt][nt][j]) + mbv[j];
      { const int col = h * 64 + dt * 16 + lq * 4; store4(y_out + ((size_t)(col >> 5) * Tn + t) * 32 + (col & 31), y); }
    }
  }
}

DI void phase5(const Params& p, int bid, int nblk, unsigned char* smem, u16* y_out) {
  for (int it = bid; it < 8192; it += nblk) selwin_item(p, it, smem, y_out);
}

DI void phase6(const Params& p, const Sched& sched, unsigned char* smem) {
  XBlk xl{(const u16*)(p.ws + OFF_KVU), Tn};
  const float* mod = (const float*)(p.ws + OFF_MOD);
  u16* x1b = (u16*)(p.ws + OFF_MA);
  for_tiles_st(256, 8, sched, [&](int tm, int tn) {
    gemm_tile<8>((const u16*)(p.ws + OFF_WO), 1024, tn * 128, tm * 256, 1024, xl, [&](f32x4 (&acc)[4][8], int fb, int tb, int lr, int lq, int wf, int wt) {
      constexpr int EST = 136;
      u16* Ls = (u16*)smem;
      const int b = tb >> 11;
      __syncthreads();
#pragma unroll
      for (int mi = 0; mi < 4; ++mi) {
        const int f = fb + mi * 16 + lq * 4; const float4 gm = *(const float4*)(mod + (size_t)b * 6144 + 2048 + f);
#pragma unroll
        for (int ni = 0; ni < 8; ++ni) {
          const f32x4 o = {gm.x * acc[mi][ni][0], gm.y * acc[mi][ni][1], gm.z * acc[mi][ni][2], gm.w * acc[mi][ni][3]};
          store4(Ls + (wt * 128 + ni * 16 + lr) * EST + wf * 64 + mi * 16 + lq * 4, o);
        }
      }
      __syncthreads();
      const int tid = tidx();
#pragma unroll
      for (int i = 0; i < 16; ++i) {
        const int c = tid + 256 * i, row = c >> 4, ch = (c & 15) * 8;
        const size_t gi = (size_t)(tm * 256 + row) * 1024 + tn * 128 + ch;
        const u32x4 sv = *(const u32x4*)(Ls + row * EST + ch);
        const f32x4 x0 = *(const f32x4*)(p.x + gi), x1 = *(const f32x4*)(p.x + gi + 4);
        u32x4 w;
        w.x = cvtpk(x0[0] + bflo(sv.x), x0[1] + bfhi(sv.x)); w.y = cvtpk(x0[2] + bflo(sv.y), x0[3] + bfhi(sv.y));
        w.z = cvtpk(x1[0] + bflo(sv.z), x1[1] + bfhi(sv.z)); w.w = cvtpk(x1[2] + bflo(sv.w), x1[3] + bfhi(sv.w));
        *(u32x4*)(x1b + gi) = w;
      }
    }, smem);
  });
}

DI void phase8(const Params& p, const Sched& sched, unsigned char* smem) {
  XBlk xl{(const u16*)(p.ws + OFF_HBUF), Tn};
  u16* act = (u16*)(p.ws + OFF_ACT);
  float* gside = (float*)(p.ws + OFF_GSIDE); float* uside = (float*)(p.ws + OFF_USIDE);
  float* gl = (float*)smem;
  for_tiles_st(256, 44, sched, [&](int tm, int tn) {
    gemm_tile<8>((const u16*)(p.ws + OFF_WGU), 5632, tn * 128, tm * 256, 1024, xl, [&](f32x4 (&acc)[4][8], int fb, int tb, int lr, int lq, int wf, int wt) {
      u16* Ls = (u16*)(smem + 36864);
#pragma unroll
      for (int h2 = 0; h2 < 2; ++h2) {
        const int fl = wf * 16 + lq * 4, fc = (2 * wf + h2) * 16 + lq * 4, F = tn * 64 + fc;
        __syncthreads();
#pragma unroll
        for (int ni = 0; ni < 8; ++ni) *(f32x4*)(gl + (wt * 128 + ni * 16 + lr) * 36 + fl) = acc[2 * h2][ni];
        __syncthreads();
        const float4 w0 = *(const float4*)(p.conv_w + F), w1 = *(const float4*)(p.conv_w + FF + F), w2 = *(const float4*)(p.conv_w + 2 * FF + F), cb = *(const float4*)(p.conv_b + F);
#pragma unroll
        for (int ni = 0; ni < 8; ++ni) {
          const int row = wt * 128 + ni * 16 + lr;
          const f32x4 gv = acc[2 * h2][ni], uv = acc[2 * h2 + 1][ni];
          if (row >= 2) {
            const f32x4 g1 = *(const f32x4*)(gl + (row - 1) * 36 + fl), g2 = *(const f32x4*)(gl + (row - 2) * 36 + fl);
            f32x4 o;
            o[0] = cb.x + w0.x * g2[0] + w1.x * g1[0] + w2.x * gv[0];
            o[1] = cb.y + w0.y * g2[1] + w1.y * g1[1] + w2.y * gv[1];
            o[2] = cb.z + w0.z * g2[2] + w1.z * g1[2] + w2.z * gv[2];
            o[3] = cb.w + w0.w * g2[3] + w1.w * g1[3] + w2.w * gv[3];
#pragma unroll
            for (int j = 0; j < 4; ++j) o[j] = o[j] * sigmoidf_(o[j]) * uv[j];
            store4(Ls + row * 72 + fc, o);
          } else {
            *(f32x4*)(gside + ((size_t)tm * 4 + row) * FF + F) = gv;
            *(f32x4*)(uside + ((size_t)tm * 2 + row) * FF + F) = uv;
          }
          if (row >= 254) *(f32x4*)(gside + ((size_t)tm * 4 + 2 + (row - 254)) * FF + F) = gv;
        }
      }
      __syncthreads();
      const int tid = tidx(), F0 = tn * 64;
#pragma unroll
      for (int i = 0; i < 8; ++i) {
        const int c = tid + 256 * i, fblk = c >> 10, row = (c & 1023) >> 2, ch = (c & 3) * 8;
        if (row >= 2) *(u32x4*)(act + ((size_t)((F0 >> 5) + fblk) * Tn + (size_t)tm * 256 + row) * 32 + ch) = *(const u32x4*)(Ls + row * 72 + fblk * 32 + ch);
      }
    }, smem);
  });
}

DI void phase8b(const Params& p, int bid, int nblk) {
  const float* gside = (const float*)(p.ws + OFF_GSIDE); const float* uside = (const float*)(p.ws + OFF_USIDE);
  u16* act = (u16*)(p.ws + OFF_ACT);
  const int total = 256 * 2 * (FF / 4);
  for (int i = bid * 256 + tidx(); i < total; i += nblk * 256) {
    const int f4 = i % (FF / 4), rr = i / (FF / 4), r = rr & 1, tm = rr >> 1, F = f4 * 4;
    const bool first = (tm & 7) == 0;
    const f32x4 z = {0.f, 0.f, 0.f, 0.f};
    const f32x4 gv = *(const f32x4*)(gside + ((size_t)tm * 4 + r) * FF + F);
    f32x4 g1, g2;
    if (r == 1) { g1 = *(const f32x4*)(gside + ((size_t)tm * 4 + 0) * FF + F); g2 = first ? z : *(const f32x4*)(gside + ((size_t)(tm - 1) * 4 + 3) * FF + F); }
    else { g1 = first ? z : *(const f32x4*)(gside + ((size_t)(tm - 1) * 4 + 3) * FF + F); g2 = first ? z : *(const f32x4*)(gside + ((size_t)(tm - 1) * 4 + 2) * FF + F); }
    const f32x4 uv = *(const f32x4*)(uside + ((size_t)tm * 2 + r) * FF + F);
    const f32x4 w0 = *(const f32x4*)(p.conv_w + F), w1 = *(const f32x4*)(p.conv_w + FF + F), w2 = *(const f32x4*)(p.conv_w + 2 * FF + F), cb = *(const f32x4*)(p.conv_b + F);
    f32x4 o = cb + w0 * g2 + w1 * g1 + w2 * gv;
#pragma unroll
    for (int j = 0; j < 4; ++j) o[j] = o[j] * sigmoidf_(o[j]) * uv[j];
    store4(act + ((size_t)(F >> 5) * Tn + (size_t)tm * 256 + r) * 32 + (F & 31), o);
  }
}

DI void phase9(const Params& p, const Sched& sched, unsigned char* smem) {
  XBlk xl{(const u16*)(p.ws + OFF_ACT), Tn};
  const float* mod = (const float*)(p.ws + OFF_MOD);
  const u16* x1b = (const u16*)(p.ws + OFF_MA); u16* x2b = (u16*)(p.ws + OFF_MB);
  for_tiles_st(256, 8, sched, [&](int tm, int tn) {
    gemm_tile<8>((const u16*)(p.ws + OFF_WDN), 1024, tn * 128, tm * 256, FF, xl, [&](f32x4 (&acc)[4][8], int fb, int tb, int lr, int lq, int wf, int wt) {
      constexpr int EST = 136;
      u16* Ls = (u16*)smem;
      const int b = tb >> 11;
      __syncthreads();
#pragma unroll
      for (int mi = 0; mi < 4; ++mi) {
        const int f = fb + mi * 16 + lq * 4; const float4 gm = *(const float4*)(mod + (size_t)b * 6144 + 5120 + f);
#pragma unroll
        for (int ni = 0; ni < 8; ++ni) {
          const f32x4 o = {gm.x * acc[mi][ni][0], gm.y * acc[mi][ni][1], gm.z * acc[mi][ni][2], gm.w * acc[mi][ni][3]};
          store4(Ls + (wt * 128 + ni * 16 + lr) * EST + wf * 64 + mi * 16 + lq * 4, o);
        }
      }
      __syncthreads();
      const int tid = tidx();
#pragma unroll
      for (int i = 0; i < 16; ++i) {
        const int c = tid + 256 * i, row = c >> 4, ch = (c & 15) * 8;
        const size_t gi = (size_t)(tm * 256 + row) * 1024 + tn * 128 + ch;
        const u32x4 sv = *(const u32x4*)(Ls + row * EST + ch), xv = *(const u32x4*)(x1b + gi);
        u32x4 w;
        w.x = cvtpk(bflo(xv.x) + bflo(sv.x), bfhi(xv.x) + bfhi(sv.x)); w.y = cvtpk(bflo(xv.y) + bflo(sv.y), bfhi(xv.y) + bfhi(sv.y));
        w.z = cvtpk(bflo(xv.z) + bflo(sv.z), bfhi(xv.z) + bfhi(sv.z)); w.w = cvtpk(bflo(xv.w) + bflo(sv.w), bfhi(xv.w) + bfhi(sv.w));
        *(u32x4*)(x2b + gi) = w;
      }
    }, smem);
  });
}

DI void phase10(const Params& p, int bid, int nblk) {
  const int lane = tidx() & 63, wave = tidx() >> 6;
  const u16* x2 = (const u16*)(p.ws + OFF_MB);
  f32x4 g4[4];
#pragma unroll
  for (int i = 0; i < 4; ++i) g4[i] = *(const f32x4*)(p.final_g + (lane + 64 * i) * 4);
  auto ldrow = [&](uint2 (&d)[4], int row) {
#pragma unroll
    for (int i = 0; i < 4; ++i) d[i] = *(const uint2*)(x2 + (size_t)row * 1024 + (lane + 64 * i) * 4);
  };
  const int step = nblk * 4;
  int row = bid * 4 + wave;
  uint2 cur[4], nxt[4];
  if (row < Tn) ldrow(cur, row);
  for (; row < Tn; row += step) {
    if (row + step < Tn) ldrow(nxt, row + step);
    f32x4 v[4]; float ss = 0.f;
#pragma unroll
    for (int i = 0; i < 4; ++i) { v[i] = (f32x4){bflo(cur[i].x), bfhi(cur[i].x), bflo(cur[i].y), bfhi(cur[i].y)}; ss += v[i][0] * v[i][0] + v[i][1] * v[i][1] + v[i][2] * v[i][2] + v[i][3] * v[i][3]; }
#pragma unroll
    for (int o = 32; o >= 1; o >>= 1) ss += __shfl_xor(ss, o);
    const float rstd = rsqrtf(ss * (1.0f / 1024.0f) + 1e-6f);
    f32x4* xr = (f32x4*)(p.out + (size_t)row * 1024);
#pragma unroll
    for (int i = 0; i < 4; ++i) xr[lane + 64 * i] = v[i] * rstd * g4[i];
#pragma unroll
    for (int i = 0; i < 4; ++i) cur[i] = nxt[i];
  }
}

#define XB_TMO      128
#define XB_XCNT(j)  (256  + 64 * (j))
#define XB_XSUB(j)  (1280 + 64 * (j))
#define XB_XGEN(j)  (2304 + 64 * (j))
#define XB_TOP      3328
#define XB_TOPGEN   3392
#define XCD_BAR_WORDS 3456
#define XB_SPIN_CAP (1u << 20)
#define LAS __attribute__((address_space(3)))
DI unsigned xb_ld(unsigned* p) { return __hip_atomic_load(p, __ATOMIC_RELAXED, __HIP_MEMORY_SCOPE_AGENT); }
DI unsigned xb_add(unsigned* p, unsigned v) { return __hip_atomic_fetch_add(p, v, __ATOMIC_RELAXED, __HIP_MEMORY_SCOPE_AGENT); }
DI unsigned xb_xcc_id() { return (unsigned)__builtin_amdgcn_s_getreg((3 << 11) | 20) & 0xFu; }
#define XB_SPIN(cond, bar) do { unsigned _sp = 0; while (cond) { __builtin_amdgcn_s_sleep(1); \
    if ((++_sp & 255u) == 0u) { if (xb_ld(&(bar)[XB_TMO])) break; if (_sp > XB_SPIN_CAP) { atomicAdd(&(bar)[XB_TMO], 1u); break; } } } } while (0)
struct XcdBarrier { unsigned* bar; unsigned x; volatile LAS unsigned* st; };
DI XcdBarrier xcd_barrier_post(unsigned* bar, volatile LAS unsigned* st) {
  XcdBarrier b; b.bar = bar; b.x = xb_xcc_id(); b.st = st;
  if (tidx() == 0) st[2] = xb_add(&bar[XB_XCNT(b.x)], 1u);
  return b;
}
DI void xcd_barrier_complete(unsigned* bar, unsigned x, unsigned& nloc, unsigned& nx) {
  const unsigned G = gridDim.x * gridDim.y * gridDim.z;
  unsigned sum, cnt, mine, sp = 0u;
  for (;;) {
    sum = 0u; cnt = 0u; mine = 0u;
#pragma unroll
    for (unsigned j = 0; j < 16; ++j) { const unsigned c = xb_ld(&bar[XB_XCNT(j)]); sum += c; cnt += (c > 0u) ? 1u : 0u; mine = (j == x) ? c : mine; }
    if (sum == G) break;
    __builtin_amdgcn_s_sleep(1);
    if ((++sp & 255u) == 0u) { if (xb_ld(&bar[XB_TMO])) break; if (sp > XB_SPIN_CAP) { atomicAdd(&bar[XB_TMO], 1u); break; } }
  }
  nloc = mine > 0u ? mine : 1u; nx = cnt > 0u ? cnt : 1u;
}
DI void xcd_barrier(const XcdBarrier& b) {
  asm volatile("s_waitcnt vmcnt(0)" ::: "memory");
  __syncthreads();
  if (tidx() == 0) {
    unsigned* bar = b.bar;
    __builtin_amdgcn_s_waitcnt(0);
    unsigned nloc = b.st[0], nx = b.st[1];
    if (nloc == 0u) { xcd_barrier_complete(bar, b.x, nloc, nx); b.st[0] = nloc; b.st[1] = nx; }
    const unsigned old = xb_add(&bar[XB_XSUB(b.x)], 1u);
    const unsigned gen = old / nloc;
    if (old + 1u == (gen + 1u) * nloc) {
      __builtin_amdgcn_fence(__ATOMIC_RELEASE, "agent");
      asm volatile("s_waitcnt vmcnt(0)" ::: "memory");
      const unsigned og = xb_add(&bar[XB_TOP], 1u);
      const unsigned tg = og / nx;
      if (og + 1u == (tg + 1u) * nx) xb_add(&bar[XB_TOPGEN], 1u);
      else XB_SPIN(xb_ld(&bar[XB_TOPGEN]) == tg, bar);
      __builtin_amdgcn_fence(__ATOMIC_ACQUIRE, "agent");
      xb_add(&bar[XB_XGEN(b.x)], 1u);
      asm volatile("s_waitcnt vmcnt(0)" ::: "memory");
    } else {
      XB_SPIN(xb_ld(&bar[XB_XGEN(b.x)]) == gen, bar);
      __builtin_amdgcn_fence(__ATOMIC_ACQUIRE, "agent");
      asm volatile("s_waitcnt vmcnt(0)" ::: "memory");
    }
  }
  __syncthreads();
}

DI void run_phase(const Params& p, int ph, int bid, int nblk, unsigned char* smem) {
  const Sched sched{bid & 7, bid >> 3, nblk >> 3, 8};
  switch (ph) {
    case 0: phase0(p, bid, nblk, smem); break;
    case 1: norm_pass<true>(p, p.x, nullptr, p.norm_mix_g, 0, 1024, bid, nblk, smem); break;
    case 2: phase1(p, sched, smem); break;
    case 3: phase2(p, bid, nblk, smem); break;
    case 4: phase3(p, bid, nblk, smem, (u16*)(p.ws + OFF_MB)); break;
    case 5: phase4(p, bid, nblk, smem); break;
    case 6: phase5(p, bid, nblk, smem, (u16*)(p.ws + OFF_KVU)); break;
    case 7: phase6(p, sched, smem); break;
    case 8: norm_pass<false>(p, nullptr, (const u16*)(p.ws + OFF_MA), p.norm_ffn_g, 3072, 4096, bid, nblk, smem); break;
    case 9: phase8(p, sched, smem); break;
    case 10: phase8b(p, bid, nblk); break;
    case 11: phase9(p, sched, smem); break;
    case 12: phase10(p, bid, nblk); break;
  }
}
constexpr int NPHASE = 13;

__global__ void __launch_bounds__(256, 2) mega_kernel(Params p) {
  __shared__ __attribute__((aligned(16))) unsigned char smem[SMEM_BYTES];
  cg::grid_group grid = cg::this_grid();
  const int bid = blockIdx.x, nblk = gridDim.x;
  __shared__ u32x4 xb_words;
  if (tidx() == 0) xb_words = (u32x4){0u, 0u, 0u, 0u};
  __syncthreads();
  const XcdBarrier xb = xcd_barrier_post((unsigned*)(p.ws + OFF_BAR), (volatile LAS unsigned*)&xb_words);
#ifndef DUP_PHASE
#define DUP_PHASE -1
#endif
#define DUP(k, stmt) if (DUP_PHASE == k) { stmt; xcd_barrier(xb); }
  if (p.ws == nullptr) grid.sync();
  phase0(p, bid, nblk, smem); xcd_barrier(xb);
  DUP(0, phase0(p, bid, nblk, smem))
  norm_pass<true>(p, p.x, nullptr, p.norm_mix_g, 0, 1024, bid, nblk, smem); xcd_barrier(xb);
  if (tidx() == 0) {
    unsigned dense = 0;
    for (unsigned j = 0; j < 16; ++j) { const unsigned c = xb_ld(&xb.bar[XB_XCNT(j)]); if (j < xb.x && c > 0u) ++dense; }
    xb_words.w = dense;
  }
  __syncthreads();
  const Sched sched{(int)xb_words.w, (int)xb_words.z, (int)xb_words.x, (int)xb_words.y};
  DUP(1, phase1(p, sched, smem))
  phase1(p, sched, smem); xcd_barrier(xb);
  DUP(2, phase2(p, bid, nblk, smem))
  phase2(p, bid, nblk, smem); xcd_barrier(xb);
  DUP(3, phase3(p, bid, nblk, smem, (u16*)p.out))
  phase3(p, bid, nblk, smem, (u16*)(p.ws + OFF_MB)); xcd_barrier(xb);
  DUP(4, phase4(p, bid, nblk, smem))
  phase4(p, bid, nblk, smem); xcd_barrier(xb);
  DUP(5, phase5(p, bid, nblk, smem, (u16*)p.out))
  phase5(p, bid, nblk, smem, (u16*)(p.ws + OFF_KVU)); xcd_barrier(xb);
  DUP(6, phase6(p, sched, smem))
  phase6(p, sched, smem); xcd_barrier(xb);
  norm_pass<false>(p, nullptr, (const u16*)(p.ws + OFF_MA), p.norm_ffn_g, 3072, 4096, bid, nblk, smem); xcd_barrier(xb);
  DUP(8, phase8(p, sched, smem))
  phase8(p, sched, smem); xcd_barrier(xb);
  phase8b(p, bid, nblk); xcd_barrier(xb);
  phase9(p, sched, smem); xcd_barrier(xb);
  phase10(p, bid, nblk);
}

#if N_LAUNCH_MODE != 0
__global__ void __launch_bounds__(256, 2) phase_kernel(Params p, int ph) {
  __shared__ __attribute__((aligned(16))) unsigned char smem[SMEM_BYTES];
  run_phase(p, ph, blockIdx.x, gridDim.x, smem);
}
#endif

#ifdef PHASE_DEBUG
template <int PH> __global__ void __launch_bounds__(256, 2) phase_dbg(Params p) {
  __shared__ __attribute__((aligned(16))) unsigned char smem[SMEM_BYTES];
  run_phase(p, PH, blockIdx.x, gridDim.x, smem);
}
template __global__ void phase_dbg<0>(Params); template __global__ void phase_dbg<1>(Params); template __global__ void phase_dbg<2>(Params);
template __global__ void phase_dbg<3>(Params); template __global__ void phase_dbg<4>(Params); template __global__ void phase_dbg<5>(Params);
template __global__ void phase_dbg<6>(Params); template __global__ void phase_dbg<7>(Params); template __global__ void phase_dbg<8>(Params);
template __global__ void phase_dbg<9>(Params); template __global__ void phase_dbg<10>(Params); template __global__ void phase_dbg<11>(Params);
template __global__ void phase_dbg<12>(Params);
#endif

extern "C" void kernel_launch(void* const* d_in, const int* in_sizes, int n_in, void* d_out, int out_size, void* d_ws, size_t ws_size,
                              hipStream_t stream) {
  if (ws_size < WS_NEED) { fprintf(stderr, "workspace too small: %zu < %zu\n", ws_size, (size_t)WS_NEED); return; }
  Params p{};
  p.x = (const float*)d_in[0]; p.c = (const float*)d_in[1]; p.pos = (const int*)d_in[2]; p.rel = (const float*)d_in[3];
  p.ada_w = (const float*)d_in[4]; p.ada_b = (const float*)d_in[5]; p.norm_mix_g = (const float*)d_in[6]; p.w_in = (const float*)d_in[7];
  p.cmp_pos_k = (const float*)d_in[8]; p.cmp_w1_k = (const float*)d_in[9]; p.cmp_w2_k = (const float*)d_in[10];
  p.cmp_pos_v = (const float*)d_in[11]; p.cmp_w1_v = (const float*)d_in[12]; p.cmp_w2_v = (const float*)d_in[13];
  p.mla_q_g = (const float*)d_in[14]; p.mla_w_uq = (const float*)d_in[15]; p.mla_kv_g = (const float*)d_in[16]; p.mla_w_ukv = (const float*)d_in[17];
  p.w_o = (const float*)d_in[18]; p.norm_ffn_g = (const float*)d_in[19]; p.w_gate = (const float*)d_in[20]; p.w_up = (const float*)d_in[21];
  p.conv_w = (const float*)d_in[22]; p.conv_b = (const float*)d_in[23]; p.w_down = (const float*)d_in[24]; p.final_g = (const float*)d_in[25];
  p.out = (float*)d_out; p.ws = (unsigned char*)d_ws;
#if N_LAUNCH_MODE == 0
  static int grid_blocks = 0;
  if (!grid_blocks) {
    int dev = 0, cus = 0, per_cu = 0;
    (void)hipGetDevice(&dev);
    (void)hipDeviceGetAttribute(&cus, hipDeviceAttributeMultiprocessorCount, dev);
    (void)hipOccupancyMaxActiveBlocksPerMultiprocessor(&per_cu, mega_kernel, 256, 0);
    if (per_cu > 2) per_cu = 2;
    if (per_cu < 1) per_cu = 1;
    grid_blocks = cus * per_cu;
  }
  (void)hipMemsetAsync((unsigned char*)d_ws + OFF_BAR, 0, 16384, stream);
  void* args[] = {&p};
  hipError_t e = hipLaunchCooperativeKernel((void*)mega_kernel, dim3(grid_blocks), dim3(256), args, 0, stream);
  if (e != hipSuccess) fprintf(stderr, "cooperative launch failed: %s (grid %d)\n", hipGetErrorString(e), grid_blocks);
#else
  for (int ph = 0; ph < NPHASE; ++ph) phase_kernel<<<512, 256, 0, stream>>>(p, ph);
#endif
}
```
